# Optimizing an MI355X kernel written in HIP

```python
import math
import jax, jax.numpy as jnp
from jax import lax
import numpy as np

D_MODEL = 1024
BATCH = 8
SEQ = 2048
DEPTH = 2

CHUNK = 64
HEAD_DIM = 64
EPS = 1e-6
NEG_INF = -1e30
A_Q_HEADS = 8
A_KV_HEADS = 2
A_GROUP = A_Q_HEADS // A_KV_HEADS
A_WINDOW = 128
A_PREV_CHUNKS = A_WINDOW // CHUNK
T5_BUCKETS = 32
T5_MAX_DIST = 128
B_HEADS = 4
B_Q_RANK = 256
B_KV_RANK = 128
B_NOPE_DIM = 64
B_ROPE_DIM = 32
B_QK_DIM = B_NOPE_DIM + B_ROPE_DIM
B_V_DIM = 64
ROPE_THETA = 10000.0
Q_BLOCK = 128
C_HEADS = 4
C_PREV_CHUNKS = 8
C_REL_CLIP = 256
C_REL_SIZE = (CHUNK - 1) + C_REL_CLIP + 1
A_WIDTH = A_Q_HEADS * HEAD_DIM
B_WIDTH = B_HEADS * B_V_DIM
C_WIDTH = C_HEADS * HEAD_DIM
MIX_WIDTH = A_WIDTH + B_WIDTH + C_WIDTH
IN_SPLITS = (A_WIDTH, A_KV_HEADS * HEAD_DIM, A_KV_HEADS * HEAD_DIM,
             B_Q_RANK, B_KV_RANK, B_ROPE_DIM,
             C_WIDTH, C_WIDTH, C_WIDTH)
IN_WIDTH = sum(IN_SPLITS)
N_EXPERTS = 32
TOP_K = 4
D_EXPERT = D_MODEL
SWIGLU_LIMIT = 7.0
SWIGLU_ALPHA = 1.702
EXPERT_BLOCK = 128

kernel_name = "hybrid_chunk_causal_trunk"


def rms_norm(x, g):
    xf = x.astype(jnp.float32)
    y = xf * lax.rsqrt(jnp.mean(xf * xf, axis=-1, keepdims=True) + EPS)
    return (y * g).astype(x.dtype)


def rope(x, pos):
    half = x.shape[-1] // 2
    inv_freq = ROPE_THETA ** (-(jnp.arange(half, dtype=jnp.float32) / half))
    ang = pos.astype(jnp.float32)[:, None] * inv_freq[None, :]
    shape = (ang.shape[0],) + (1,) * (x.ndim - 3) + (half,)
    cos = jnp.cos(ang).reshape(shape)
    sin = jnp.sin(ang).reshape(shape)
    xf = x.astype(jnp.float32)
    x1, x2 = xf[..., :half], xf[..., half:]
    return jnp.concatenate([x1 * cos - x2 * sin, x2 * cos + x1 * sin], axis=-1).astype(x.dtype)


def chunk_band(t, n_prev):
    b, s, h, d = t.shape
    nc = s // CHUNK
    tc = t.reshape(b, nc, CHUNK, h, d)
    tp = jnp.pad(tc, ((0, 0), (n_prev, 0), (0, 0), (0, 0), (0, 0)))
    idx = jnp.arange(nc)[:, None] + jnp.arange(n_prev + 1)[None, :]
    return tp[:, idx].reshape(b, nc, (n_prev + 1) * CHUNK, h, d)


def band_valid(nc, n_prev):
    key_chunk = jnp.arange(nc)[:, None] - n_prev + jnp.arange((n_prev + 1) * CHUNK)[None, :] // CHUNK
    return key_chunk >= 0


def t5_bucket(rel):
    half = T5_BUCKETS // 2
    max_exact = half // 2
    ret = jnp.where(rel > 0, half, 0)
    n = jnp.abs(rel)
    nf = jnp.maximum(n, 1).astype(jnp.float32)
    large = max_exact + (jnp.log(nf / max_exact) / math.log(T5_MAX_DIST / max_exact)
                         * (half - max_exact)).astype(jnp.int32)
    large = jnp.minimum(large, half - 1)
    return ret + jnp.where(n < max_exact, n, large)


def sliding_window_gqa(q, k, v, q_gain, k_gain, sinks, t5_bias):
    b, s, _ = q.shape
    nc = s // CHUNK
    q = rms_norm(q.reshape(b, s, A_KV_HEADS, A_GROUP, HEAD_DIM), q_gain)
    k = rms_norm(k.reshape(b, s, A_KV_HEADS, HEAD_DIM), k_gain)
    v = v.reshape(b, s, A_KV_HEADS, HEAD_DIM)
    qc = q.reshape(b, nc, CHUNK, A_KV_HEADS, A_GROUP, HEAD_DIM)
    kb = chunk_band(k, A_PREV_CHUNKS)
    vb = chunk_band(v, A_PREV_CHUNKS)
    valid = band_valid(nc, A_PREV_CHUNKS)
    logits = jnp.einsum("bnqhgd,bnkhd->bnhgqk", qc, kb).astype(jnp.float32) * (HEAD_DIM ** -0.5) + t5_bias
    logits = jnp.where(valid[None, :, None, None, None, :], logits, NEG_INF)
    sink = sinks.reshape(A_KV_HEADS, A_GROUP)[:, :, None, None].astype(jnp.float32)
    m = jnp.maximum(jnp.max(logits, axis=-1, keepdims=True), sink)
    e = jnp.exp(logits - m)
    p = e / (jnp.sum(e, axis=-1, keepdims=True) + jnp.exp(sink - m))
    o = jnp.einsum("bnhgqk,bnkhd->bnqhgd", p.astype(v.dtype), vb)
    return o.reshape(b, s, A_WIDTH)


def block_causal_attention(q, k, v):
    b, s, h, dq = q.shape
    dv = v.shape[-1]
    nqb = s // Q_BLOCK
    qb = q.reshape(b, nqb, Q_BLOCK, h, dq).transpose(1, 0, 2, 3, 4)
    key_chunk = jnp.arange(s) // CHUNK
    scale = dq ** -0.5

    def one_block(args):
        q_blk, blk = args
        q_chunk = (blk * Q_BLOCK + jnp.arange(Q_BLOCK)) // CHUNK
        mask = key_chunk[None, :] <= q_chunk[:, None]
        logits = jnp.einsum("bqhd,bkhd->bhqk", q_blk, k).astype(jnp.float32) * scale
        p = jax.nn.softmax(jnp.where(mask, logits, NEG_INF), axis=-1)
        return jnp.einsum("bhqk,bkhd->bqhd", p.astype(v.dtype), v)

    out = lax.map(one_block, (qb, jnp.arange(nqb)))
    return out.transpose(1, 0, 2, 3, 4).reshape(b, s, h * dv)


def latent_attention(c_q, c_kv, k_pe, q_a_gain, w_q_b, kv_a_gain, w_kv_b, q_gain, k_gain, pos):
    b, s, _ = c_q.shape
    q = (rms_norm(c_q, q_a_gain) @ w_q_b).reshape(b, s, B_HEADS, B_QK_DIM)
    kv = (rms_norm(c_kv, kv_a_gain) @ w_kv_b).reshape(b, s, B_HEADS, B_NOPE_DIM + B_V_DIM)
    k_nope, v = kv[..., :B_NOPE_DIM], kv[..., B_NOPE_DIM:]
    q_nope = rms_norm(q[..., :B_NOPE_DIM], q_gain[:B_NOPE_DIM])
    q_pe = rope(rms_norm(q[..., B_NOPE_DIM:], q_gain[B_NOPE_DIM:]), pos)
    k_nope = rms_norm(k_nope, k_gain[:B_NOPE_DIM])
    k_pe = rope(rms_norm(k_pe, k_gain[B_NOPE_DIM:]), pos)
    qf = jnp.concatenate([q_nope, q_pe], axis=-1)
    kf = jnp.concatenate([k_nope, jnp.broadcast_to(k_pe[:, :, None, :], (b, s, B_HEADS, B_ROPE_DIM))], axis=-1)
    return block_causal_attention(qf, kf, v)


def chunk_relbias_attention(q, k, v, q_gain, k_gain, rel_table, rel_idx):
    b, s, _ = q.shape
    nc = s // CHUNK
    q = rms_norm(q.reshape(b, s, C_HEADS, HEAD_DIM), q_gain)
    k = rms_norm(k.reshape(b, s, C_HEADS, HEAD_DIM), k_gain)
    v = v.reshape(b, s, C_HEADS, HEAD_DIM)
    qc = q.reshape(b, nc, CHUNK, C_HEADS, HEAD_DIM)
    kb = chunk_band(k, C_PREV_CHUNKS)
    vb = chunk_band(v, C_PREV_CHUNKS)
    valid = band_valid(nc, C_PREV_CHUNKS)
    bias = rel_table[rel_idx].transpose(2, 0, 1).astype(jnp.float32)
    logits = jnp.einsum("bnqhd,bnkhd->bnhqk", qc, kb).astype(jnp.float32) * (HEAD_DIM ** -0.5) + bias
    p = jax.nn.softmax(jnp.where(valid[None, :, None, None, :], logits, NEG_INF), axis=-1)
    o = jnp.einsum("bnhqk,bnkhd->bnqhd", p.astype(v.dtype), vb)
    return o.reshape(b, s, C_WIDTH)


def clamped_swiglu(hgu):
    glu, lin = hgu[..., :D_EXPERT], hgu[..., D_EXPERT:]
    glu = jnp.minimum(glu, SWIGLU_LIMIT)
    lin = jnp.clip(lin, -SWIGLU_LIMIT, SWIGLU_LIMIT)
    return glu * jax.nn.sigmoid(SWIGLU_ALPHA * glu) * (lin + 1.0)


def moe_ffn(h, w_router, b_router, w_gu, b_gu, w_down, b_down):
    b, s, d = h.shape
    t = b * s
    xf = h.reshape(t, d)
    logits = (xf @ w_router + b_router).astype(jnp.float32)
    top_vals, top_idx = lax.top_k(logits, TOP_K)
    gates = jax.nn.softmax(top_vals, axis=-1)
    tk = t * TOP_K
    flat_e = top_idx.reshape(-1)
    flat_tok = jnp.arange(tk, dtype=jnp.int32) // TOP_K
    flat_g = gates.reshape(-1)
    order = jnp.argsort(flat_e)
    se, stok, sg = flat_e[order], flat_tok[order], flat_g[order]
    counts = jnp.zeros((N_EXPERTS,), jnp.int32).at[flat_e].add(1)
    padded = (counts + EXPERT_BLOCK - 1) // EXPERT_BLOCK * EXPERT_BLOCK
    pad_end = jnp.cumsum(padded)
    pad_start = pad_end - padded
    start = jnp.cumsum(counts) - counts
    dest = pad_start[se] + (jnp.arange(tk, dtype=jnp.int32) - start[se])
    n_blocks = -(-(tk + N_EXPERTS * EXPERT_BLOCK) // EXPERT_BLOCK)
    n_rows = n_blocks * EXPERT_BLOCK
    row_tok = jnp.full((n_rows,), t, jnp.int32).at[dest].set(stok)
    row_gate = jnp.zeros((n_rows,), jnp.float32).at[dest].set(sg)
    x_pad = jnp.concatenate([xf, jnp.zeros((1, d), xf.dtype)], axis=0)
    x_rows = x_pad[row_tok].reshape(n_blocks, EXPERT_BLOCK, d)
    blk_e = jnp.minimum(jnp.searchsorted(pad_end, jnp.arange(n_blocks, dtype=jnp.int32) * EXPERT_BLOCK,
                                         side="right"), N_EXPERTS - 1)

    def expert_block(args):
        xb, e = args
        hgu = xb @ w_gu[e] + b_gu[e]
        return clamped_swiglu(hgu) @ w_down[e] + b_down[e]

    y_rows = lax.map(expert_block, (x_rows, blk_e)).reshape(n_rows, d)
    y = jax.ops.segment_sum(y_rows * row_gate[:, None].astype(y_rows.dtype), row_tok, num_segments=t + 1)[:t]
    return y.astype(h.dtype).reshape(b, s, d)


def setup_inputs(seed: int = 0) -> dict:
    key = jax.random.key(seed)
    ks = jax.random.split(key, 32)
    L = DEPTH
    f32 = jnp.float32

    def nrm(k, shape, scale):
        return jax.random.normal(k, shape, f32) * scale

    def gain(k, shape):
        return 1.0 + 0.05 * jax.random.normal(k, shape, f32)

    return {
        "x": nrm(ks[0], (BATCH, SEQ, D_MODEL), 1.0),
        "attn_norm": gain(ks[1], (L, D_MODEL)),
        "w_in": nrm(ks[2], (L, D_MODEL, IN_WIDTH), D_MODEL ** -0.5),
        "a_q_norm": gain(ks[3], (L, HEAD_DIM)),
        "a_k_norm": gain(ks[4], (L, HEAD_DIM)),
        "a_sinks": nrm(ks[5], (L, A_Q_HEADS), 0.5),
        "t5_bias": nrm(ks[6], (T5_BUCKETS, A_Q_HEADS), 0.2),
        "b_q_a_norm": gain(ks[7], (L, B_Q_RANK)),
        "b_w_q_b": nrm(ks[8], (L, B_Q_RANK, B_HEADS * B_QK_DIM), B_Q_RANK ** -0.5),
        "b_kv_a_norm": gain(ks[9], (L, B_KV_RANK)),
        "b_w_kv_b": nrm(ks[10], (L, B_KV_RANK, B_HEADS * (B_NOPE_DIM + B_V_DIM)), B_KV_RANK ** -0.5),
        "b_q_norm": gain(ks[11], (L, B_QK_DIM)),
        "b_k_norm": gain(ks[12], (L, B_QK_DIM)),
        "c_q_norm": gain(ks[13], (L, HEAD_DIM)),
        "c_k_norm": gain(ks[14], (L, HEAD_DIM)),
        "c_rel_bias": nrm(ks[15], (L, C_REL_SIZE, C_HEADS), 0.2),
        "a_out_norm": gain(ks[16], (L, A_WIDTH)),
        "b_out_norm": gain(ks[17], (L, B_WIDTH)),
        "c_out_norm": gain(ks[18], (L, C_WIDTH)),
        "w_out": nrm(ks[19], (L, MIX_WIDTH, D_MODEL), MIX_WIDTH ** -0.5),
        "ffn_norm": gain(ks[20], (L, D_MODEL)),
        "w_router": nrm(ks[21], (L, D_MODEL, N_EXPERTS), D_MODEL ** -0.5),
        "b_router": nrm(ks[22], (L, N_EXPERTS), 0.01),
        "w_gate_up": nrm(ks[23], (L, N_EXPERTS, D_MODEL, 2 * D_EXPERT), D_MODEL ** -0.5),
        "b_gate_up": nrm(ks[24], (L, N_EXPERTS, 2 * D_EXPERT), 0.01),
        "w_down": nrm(ks[25], (L, N_EXPERTS, D_EXPERT, D_MODEL), D_EXPERT ** -0.5),
        "b_down": nrm(ks[26], (L, N_EXPERTS, D_MODEL), 0.01),
    }


def reference(x, attn_norm, w_in, a_q_norm, a_k_norm, a_sinks, t5_bias, b_q_a_norm, b_w_q_b,
              b_kv_a_norm, b_w_kv_b, b_q_norm, b_k_norm, c_q_norm, c_k_norm, c_rel_bias,
              a_out_norm, b_out_norm, c_out_norm, w_out, ffn_norm, w_router, b_router,
              w_gate_up, b_gate_up, w_down, b_down):
    s = x.shape[1]
    pos = jnp.arange(s)
    split_at = np.cumsum(IN_SPLITS)[:-1].tolist()
    wa = (A_PREV_CHUNKS + 1) * CHUNK
    rel_a = jnp.arange(wa)[None, :] - A_PREV_CHUNKS * CHUNK - jnp.arange(CHUNK)[:, None]
    a_bias = t5_bias[t5_bucket(rel_a)].transpose(2, 0, 1).reshape(A_KV_HEADS, A_GROUP, CHUNK, wa)
    a_bias = a_bias.astype(jnp.float32)
    wc = (C_PREV_CHUNKS + 1) * CHUNK
    dist_c = jnp.arange(CHUNK)[:, None] + C_PREV_CHUNKS * CHUNK - jnp.arange(wc)[None, :]
    rel_idx_c = jnp.clip(dist_c, -(CHUNK - 1), C_REL_CLIP) + (CHUNK - 1)

    for l in range(DEPTH):
        h = rms_norm(x, attn_norm[l])
        proj = h @ w_in[l]
        aq, ak, av, bcq, bckv, bkpe, cq, ck, cv = jnp.split(proj, split_at, axis=-1)
        o_a = sliding_window_gqa(aq, ak, av, a_q_norm[l], a_k_norm[l], a_sinks[l], a_bias)
        o_b = latent_attention(bcq, bckv, bkpe, b_q_a_norm[l], b_w_q_b[l], b_kv_a_norm[l], b_w_kv_b[l],
                               b_q_norm[l], b_k_norm[l], pos)
        o_c = chunk_relbias_attention(cq, ck, cv, c_q_norm[l], c_k_norm[l], c_rel_bias[l], rel_idx_c)
        o = jnp.concatenate([rms_norm(o_a, a_out_norm[l]), rms_norm(o_b, b_out_norm[l]),
                             rms_norm(o_c, c_out_norm[l])], axis=-1)
        x = x + o @ w_out[l]
        x = x + moe_ffn(rms_norm(x, ffn_norm[l]), w_router[l], b_router[l], w_gate_up[l],
                        b_gate_up[l], w_down[l], b_down[l])
    return x
```

```cpp
#include <hip/hip_runtime.h>
#include <cstdio>
#include <cstdint>

#ifndef MK_ONE_LAUNCH
#define MK_ONE_LAUNCH 0
#endif

#define GAS __attribute__((address_space(1)))
#define LAS __attribute__((address_space(3)))
typedef unsigned short bf16;
typedef float f32x4 __attribute__((ext_vector_type(4)));
typedef short bf16x8 __attribute__((ext_vector_type(8)));
typedef unsigned u32x4 __attribute__((ext_vector_type(4)));
typedef unsigned u32x2 __attribute__((ext_vector_type(2)));

constexpr int T = 16384, SEQ = 2048, NBATCH = 8, D = 1024, NLAYER = 2, CHUNK = 64, NCH = 32;
constexpr int IN_W = 1952, NEXP = 32, TOPK = 4, DEXP = 1024;
constexpr float EPS = 1e-6f, LOG2E = 1.4426950408889634f;
constexpr float QSCALE_AC = 0.125f * LOG2E;
constexpr float QSCALE_B = 0.10206207261596575f * LOG2E;
constexpr int NROWS_MAX = (256 + 32) * 256;
constexpr int LIST_CAP = 16384;

constexpr size_t MiB = 1u << 20;
constexpr size_t WS_CTL = 0, CTL_ZERO_BYTES = 1 * MiB;
constexpr size_t WS_RSTD = 18 * MiB, WS_OSS = 19 * MiB, WS_SS1 = 20 * MiB, WS_TOPI = 21 * MiB, WS_GATE = 22 * MiB, WS_LIST = 24 * MiB;
constexpr size_t WS_XB = 32 * MiB, WS_QA = 64 * MiB, WS_KA = 80 * MiB, WS_VA = 84 * MiB, WS_QC = 88 * MiB, WS_KC = 96 * MiB, WS_VC = 104 * MiB;
constexpr size_t WS_BRAW = 112 * MiB, WS_QB = 128 * MiB, WS_KBN = 144 * MiB, WS_VB = 152 * MiB, WS_KPE = 160 * MiB, WS_O = 176 * MiB;
constexpr size_t WS_ACT = 640 * MiB, WS_Y = 800 * MiB;
constexpr size_t WS_SCR = 1024 * MiB;
constexpr size_t WS_CQN = 1700 * MiB, WS_CKVN = 1708 * MiB, WS_QBRAW = 1712 * MiB, WS_KVBRAW = 1744 * MiB, WS_ON = 1784 * MiB, WS_C2 = 1816 * MiB, WS_END = 1880 * MiB;
constexpr int CW_BAR = 4096;
constexpr int CW_CNT = 16384;

constexpr int LDS_BYTES = 147456;
constexpr int NWAVES = 8, NTHREADS = 512;

__device__ __forceinline__ unsigned f2bf(float f) { unsigned u = __builtin_bit_cast(unsigned, f); return (u + 0x7fffu + ((u >> 16) & 1u)) >> 16; }
__device__ __forceinline__ unsigned pk2(float lo, float hi) { return f2bf(lo) | (f2bf(hi) << 16); }
__device__ __forceinline__ float bf2f(unsigned short b) { return __builtin_bit_cast(float, ((unsigned)b) << 16); }
__device__ __forceinline__ float bflo(unsigned w) { return __builtin_bit_cast(float, w << 16); }
__device__ __forceinline__ float bfhi(unsigned w) { return __builtin_bit_cast(float, w & 0xffff0000u); }
__device__ __forceinline__ float wave_sum(float v) {
#pragma unroll
    for (int o = 1; o < 64; o <<= 1) v += __shfl_xor(v, o);
    return v;
}
__device__ __forceinline__ unsigned ld_agent(const unsigned* p) { return __hip_atomic_load(p, __ATOMIC_RELAXED, __HIP_MEMORY_SCOPE_AGENT); }

#define XB_TMO      128
#define XB_XCNT(j)  (256  + 64 * (j))
#define XB_XSUB(j)  (1280 + 64 * (j))
#define XB_XGEN(j)  (2304 + 64 * (j))
#define XB_TOP      3328
#define XB_TOPGEN   3392
#define XCD_BAR_WORDS 3456
#define XB_SPIN_CAP (1u << 18)
__device__ __forceinline__ unsigned xb_ld(unsigned* p)              { return __hip_atomic_load(p, __ATOMIC_RELAXED, __HIP_MEMORY_SCOPE_AGENT); }
__device__ __forceinline__ unsigned xb_add(unsigned* p, unsigned v) { return __hip_atomic_fetch_add(p, v, __ATOMIC_RELAXED, __HIP_MEMORY_SCOPE_AGENT); }
__device__ __forceinline__ unsigned xb_xcc_id() { return (unsigned)__builtin_amdgcn_s_getreg((3 << 11) | 20) & 0xFu; }
#define XB_SPIN(cond, bar) do { unsigned _sp = 0; while (cond) { __builtin_amdgcn_s_sleep(1); \
    if ((++_sp & 255u) == 0u) { if (xb_ld(&(bar)[XB_TMO])) break; if (_sp > XB_SPIN_CAP) { atomicAdd(&(bar)[XB_TMO], 1u); break; } } } } while (0)
struct XcdBarrier { unsigned* bar; unsigned x; volatile LAS unsigned* st; };
__device__ __forceinline__ XcdBarrier xcd_barrier_post(unsigned* bar, volatile LAS unsigned* st) {
    XcdBarrier b; b.bar = bar; b.x = xb_xcc_id(); b.st = st;
    if (threadIdx.x == 0) (void)xb_add(&bar[XB_XCNT(b.x)], 1u);
    return b;
}
__device__ __forceinline__ void xcd_barrier_complete(unsigned* bar, unsigned x, unsigned& nloc, unsigned& nx) {
    const unsigned G = gridDim.x * gridDim.y * gridDim.z;
    unsigned sum, cnt, mine, sp = 0u;
    for (;;) {
        sum = 0u; cnt = 0u; mine = 0u;
#pragma unroll
        for (unsigned j = 0; j < 16; ++j) { const unsigned c = xb_ld(&bar[XB_XCNT(j)]); sum += c; cnt += (c > 0u) ? 1u : 0u; mine = (j == x) ? c : mine; }
        if (sum == G) break;
        __builtin_amdgcn_s_sleep(1);
        if ((++sp & 255u) == 0u) { if (xb_ld(&bar[XB_TMO])) break; if (sp > XB_SPIN_CAP) { atomicAdd(&bar[XB_TMO], 1u); break; } }
    }
    nloc = mine > 0u ? mine : 1u; nx = cnt > 0u ? cnt : 1u;
}
__device__ __forceinline__ void xcd_barrier(const XcdBarrier& b) {
    asm volatile("s_waitcnt vmcnt(0)" ::: "memory");
    __syncthreads();
    if (threadIdx.x == 0) {
        unsigned* bar = b.bar;
        __builtin_amdgcn_s_waitcnt(0);
        unsigned nloc = b.st[0], nx = b.st[1];
        if (nloc == 0u) { xcd_barrier_complete(bar, b.x, nloc, nx); b.st[0] = nloc; b.st[1] = nx; }
        const unsigned old = xb_add(&bar[XB_XSUB(b.x)], 1u);
        const unsigned gen = old / nloc;
        if (old + 1u == (gen + 1u) * nloc) {
            __builtin_amdgcn_fence(__ATOMIC_RELEASE, "agent");
            asm volatile("s_waitcnt vmcnt(0)" ::: "memory");
            const unsigned og = xb_add(&bar[XB_TOP], 1u);
            const unsigned tg = og / nx;
            if (og + 1u == (tg + 1u) * nx) xb_add(&bar[XB_TOPGEN], 1u);
            else XB_SPIN(xb_ld(&bar[XB_TOPGEN]) == tg, bar);
            __builtin_amdgcn_fence(__ATOMIC_ACQUIRE, "agent");
            xb_add(&bar[XB_XGEN(b.x)], 1u);
            asm volatile("s_waitcnt vmcnt(0)" ::: "memory");
        } else {
            XB_SPIN(xb_ld(&bar[XB_XGEN(b.x)]) == gen, bar);
            __builtin_amdgcn_fence(__ATOMIC_ACQUIRE, "agent");
            asm volatile("s_waitcnt vmcnt(0)" ::: "memory");
        }
    }
    __syncthreads();
}

struct Params { const float* in[27]; float* out; unsigned char* ws; int ph_lo, ph_hi; };
enum { I_X = 0, I_ATTN_NORM, I_W_IN, I_AQN, I_AKN, I_ASINK, I_T5, I_BQAN, I_BWQB, I_BKVAN, I_BWKVB, I_BQN, I_BKN, I_CQN, I_CKN, I_CREL,
       I_AON, I_BON, I_CON, I_WOUT, I_FFN_NORM, I_WR, I_BR, I_WGU, I_BGU, I_WDN, I_BDN };

struct Gain { const float* g1; const float* g2; const float* g3; int s1, s2;
    __device__ __forceinline__ float get(int k) const { return g1 == nullptr ? 1.f : (k < s1 ? g1[k] : (k < s2 ? g2[k - s1] : g3[k - s2])); } };
__device__ __forceinline__ Gain gain1(const float* g) { Gain r; r.g1 = g; r.g2 = g; r.g3 = g; r.s1 = 1 << 30; r.s2 = 1 << 30; return r; }
__device__ __forceinline__ void naive_gemm(LAS float* lds, const bf16* A, int lda, const int* rowmap, int M, const float* W, int ldw, const Gain gk,
                                           int N, int K, float* C, int ldc, int bid, int nb) {
    LAS float* As = lds;
    LAS float* Ws = lds + 32 * 68;
    const int tid = threadIdx.x, ty = tid >> 5, tx = tid & 31;
    const int ntm = (M + 63) / 64, ntn = (N + 127) / 128;
    for (int tile = bid; tile < ntm * ntn; tile += nb) {
        const int tm = tile / ntn, tn = tile % ntn, m0 = tm * 64, n0 = tn * 128;
        float acc[4][4];
#pragma unroll
        for (int i = 0; i < 4; ++i)
#pragma unroll
            for (int j = 0; j < 4; ++j) acc[i][j] = 0.f;
        for (int k0 = 0; k0 < K; k0 += 32) {
            { const int r = tid >> 3, kq = (tid & 7) * 4, m = m0 + r; float v[4] = {0.f, 0.f, 0.f, 0.f};
              if (m < M) { const int ar = rowmap ? (rowmap[m] >> 2) : m; const uint2 raw = *(const uint2*)(A + (size_t)ar * lda + k0 + kq);
                  v[0] = bflo(raw.x); v[1] = bfhi(raw.x); v[2] = bflo(raw.y); v[3] = bfhi(raw.y); }
#pragma unroll
              for (int i = 0; i < 4; ++i) As[(kq + i) * 68 + r] = v[i] * gk.get(k0 + kq + i); }
            { const int k = tid >> 4, nq = (tid & 15) * 8; const float* p = W + (size_t)(k0 + k) * ldw + n0 + nq;
#pragma unroll
              for (int j = 0; j < 8; ++j) Ws[k * 128 + nq + j] = (n0 + nq + j < N) ? p[j] : 0.f; }
            __syncthreads();
#pragma unroll 8
            for (int k = 0; k < 32; ++k) {
                const f32x4 a = *(const LAS f32x4*)(As + k * 68 + ty * 4), w = *(const LAS f32x4*)(Ws + k * 128 + tx * 4);
#pragma unroll
                for (int i = 0; i < 4; ++i)
#pragma unroll
                    for (int j = 0; j < 4; ++j) acc[i][j] += a[i] * w[j];
            }
            __syncthreads();
        }
#pragma unroll
        for (int i = 0; i < 4; ++i) { const int m = m0 + ty * 4 + i; if (m < M) {
#pragma unroll
            for (int j = 0; j < 4; ++j) { const int n = n0 + tx * 4 + j; if (n < N) C[(size_t)m * ldc + n] = acc[i][j]; } } }
    }
}

__device__ __forceinline__ int t5_bucket(int rel) {
    const int ret = rel > 0 ? 16 : 0; const int n = rel < 0 ? -rel : rel;
    if (n < 8) return ret + n;
    int large = 2 + (31 - __builtin_clz((unsigned)(n * n)));
    large = large > 15 ? 15 : large;
    return ret + large;
}

struct ExpTab { int cnt[32]; int rowbase[33]; };
__device__ __forceinline__ void load_exptab(LAS int* tab, const unsigned* ctl, int layer) {
    if (threadIdx.x < 32) tab[threadIdx.x] = (int)ld_agent(ctl + CW_CNT + (layer * 32 + threadIdx.x) * 64);
    __syncthreads();
    if (threadIdx.x == 0) { int rb = 0; for (int e = 0; e < 32; ++e) { tab[32 + e] = rb; rb += ((tab[e] + 255) / 256) * 256; } tab[64] = rb; }
    __syncthreads();
}

template <unsigned MASK> __global__ void __launch_bounds__(NTHREADS, 2) fwd(Params p) {
    extern __shared__ __attribute__((aligned(16))) unsigned char lds_raw[];
    LAS unsigned char* lds = (LAS unsigned char*)lds_raw;
    const int tid = threadIdx.x, lane = tid & 63, wave = __builtin_amdgcn_readfirstlane(tid >> 6);
    const int G = gridDim.x, bid = blockIdx.x;
    const int gw = bid * NWAVES + wave, NGW = G * NWAVES;
    unsigned char* ws = p.ws;
    unsigned* ctl = (unsigned*)(ws + WS_CTL);
    volatile LAS unsigned* MISC = (volatile LAS unsigned*)(lds + LDS_BYTES - 128);
    if (tid < 32) MISC[tid] = 0u;
    __syncthreads();
    XcdBarrier bar; bar.bar = ctl + CW_BAR; bar.x = 0; bar.st = nullptr;
    if (MK_ONE_LAUNCH) bar = xcd_barrier_post(ctl + CW_BAR, MISC + 8);
    const int lo = p.ph_lo, hi = p.ph_hi;
#define IN(k) (lo <= (k) && (k) < hi)
#define SEAM(k) do { if (MK_ONE_LAUNCH && (k) + 1 < hi) xcd_barrier(bar); } while (0)

#define RSTD ((float*)(ws + WS_RSTD))
#define OSS ((float*)(ws + WS_OSS))
#define SS1 ((float*)(ws + WS_SS1))
#define TOPI ((int*)(ws + WS_TOPI))
#define GATE ((float*)(ws + WS_GATE))
#define LIST ((int*)(ws + WS_LIST))
#define XB ((bf16*)(ws + WS_XB))
#define QA ((bf16*)(ws + WS_QA))
#define KA ((bf16*)(ws + WS_KA))
#define VA ((bf16*)(ws + WS_VA))
#define QC ((bf16*)(ws + WS_QC))
#define KC ((bf16*)(ws + WS_KC))
#define VC ((bf16*)(ws + WS_VC))
#define BRAW ((bf16*)(ws + WS_BRAW))
#define QB ((bf16*)(ws + WS_QB))
#define KBN ((bf16*)(ws + WS_KBN))
#define VB ((bf16*)(ws + WS_VB))
#define KPE ((bf16*)(ws + WS_KPE))
#define OB ((bf16*)(ws + WS_O))
#define ACT ((bf16*)(ws + WS_ACT))
#define YB ((bf16*)(ws + WS_Y))
#define SCR ((float*)(ws + WS_SCR))
#define CQN ((bf16*)(ws + WS_CQN))
#define CKVN ((bf16*)(ws + WS_CKVN))
#define QBRAW ((float*)(ws + WS_QBRAW))
#define KVBRAW ((float*)(ws + WS_KVBRAW))
#define ON ((bf16*)(ws + WS_ON))
#define C2 ((float*)(ws + WS_C2))
    float* XRES = p.out;

    for (int l = 0; l < NLAYER + 1; ++l) {
        const int PB = 1 + 16 * l;
        if (((MASK >> 0) & 1) && IN(PB + 0)) {
            const float* xin = p.in[I_X];
            for (int t = gw; t < T; t += NGW) {
                f32x4 v[4]; float ss = 0.f;
#pragma unroll
                for (int j = 0; j < 4; ++j) {
                    const int c = 256 * j + 4 * lane;
                    if (l == 0) v[j] = *(const f32x4*)(xin + (size_t)t * D + c);
                    else { v[j] = *(const f32x4*)(XRES + (size_t)t * D + c);
#pragma unroll
                        for (int k = 0; k < 4; ++k) { const uint2 y = *(const uint2*)(YB + ((size_t)t * 4 + k) * D + c);
                            v[j].x += bflo(y.x); v[j].y += bfhi(y.x); v[j].z += bflo(y.y); v[j].w += bfhi(y.y); } }
                    ss += (v[j].x * v[j].x + v[j].y * v[j].y) + (v[j].z * v[j].z + v[j].w * v[j].w);
                    *(f32x4*)(XRES + (size_t)t * D + c) = v[j];
                    if (l < NLAYER) { uint2 o; o.x = pk2(v[j].x, v[j].y); o.y = pk2(v[j].z, v[j].w); *(uint2*)(XB + (size_t)t * D + c) = o; }
                }
                ss = wave_sum(ss);
                if (lane == 0 && l < NLAYER) RSTD[t] = 1.0f / sqrtf(ss * (1.0f / D) + EPS);
            }
            SEAM(PB + 0);
        }
        if (l == NLAYER) break;
        if (((MASK >> 1) & 1) && IN(PB + 1)) {
            naive_gemm((LAS float*)lds, XB, D, nullptr, T, p.in[I_W_IN] + (size_t)l * D * IN_W, IN_W, gain1(p.in[I_ATTN_NORM] + l * D), IN_W, D, SCR, IN_W, bid, G);
            SEAM(PB + 1);
        }
        if (((MASK >> 2) & 1) && IN(PB + 2)) {
            const float* aqn = p.in[I_AQN] + l * 64; const float* akn = p.in[I_AKN] + l * 64; const float* cqn = p.in[I_CQN] + l * 64; const float* ckn = p.in[I_CKN] + l * 64;
            for (int t = gw; t < T; t += NGW) {
                const float rs = RSTD[t]; const float* pr = SCR + (size_t)t * IN_W;
                for (int h = 0; h < 8; ++h) { const float v = pr[h * 64 + lane] * rs; const float ss = wave_sum(v * v);
                    QA[(size_t)t * 512 + h * 64 + lane] = (bf16)f2bf(v * (1.0f / sqrtf(ss * (1.f / 64) + EPS)) * aqn[lane] * QSCALE_AC); }
                for (int h = 0; h < 2; ++h) { const float v = pr[512 + h * 64 + lane] * rs; const float ss = wave_sum(v * v);
                    KA[(size_t)t * 128 + h * 64 + lane] = (bf16)f2bf(v * (1.0f / sqrtf(ss * (1.f / 64) + EPS)) * akn[lane]); }
                for (int h = 0; h < 2; ++h) VA[(size_t)t * 128 + h * 64 + lane] = (bf16)f2bf(pr[640 + h * 64 + lane] * rs);
                for (int j = 0; j < 7; ++j) { const int c = j * 64 + lane; if (c < 416) BRAW[(size_t)t * 512 + c] = (bf16)f2bf(pr[768 + c] * rs); }
                for (int h = 0; h < 4; ++h) { const float v = pr[1184 + h * 64 + lane] * rs; const float ss = wave_sum(v * v);
                    QC[(size_t)t * 256 + h * 64 + lane] = (bf16)f2bf(v * (1.0f / sqrtf(ss * (1.f / 64) + EPS)) * cqn[lane] * QSCALE_AC); }
                for (int h = 0; h < 4; ++h) { const float v = pr[1440 + h * 64 + lane] * rs; const float ss = wave_sum(v * v);
                    KC[(size_t)t * 256 + h * 64 + lane] = (bf16)f2bf(v * (1.0f / sqrtf(ss * (1.f / 64) + EPS)) * ckn[lane]); }
                for (int h = 0; h < 4; ++h) VC[(size_t)t * 256 + h * 64 + lane] = (bf16)f2bf(pr[1696 + h * 64 + lane] * rs);
            }
            SEAM(PB + 2);
        }
        if (((MASK >> 3) & 1) && IN(PB + 3)) {
            const float* bkn = p.in[I_BKN] + l * 96;
            for (int t = gw; t < T; t += NGW) {
                const bf16* br = BRAW + (size_t)t * 512;
                float c[4]; float ss = 0.f;
#pragma unroll
                for (int j = 0; j < 4; ++j) { c[j] = bf2f(br[j * 64 + lane]); ss += c[j] * c[j]; }
                ss = wave_sum(ss); const float r1 = 1.0f / sqrtf(ss * (1.f / 256) + EPS);
#pragma unroll
                for (int j = 0; j < 4; ++j) CQN[(size_t)t * 256 + j * 64 + lane] = (bf16)f2bf(c[j] * r1);
                float d[2]; float s2 = 0.f;
#pragma unroll
                for (int j = 0; j < 2; ++j) { d[j] = bf2f(br[256 + j * 64 + lane]); s2 += d[j] * d[j]; }
                s2 = wave_sum(s2); const float r2 = 1.0f / sqrtf(s2 * (1.f / 128) + EPS);
#pragma unroll
                for (int j = 0; j < 2; ++j) CKVN[(size_t)t * 128 + j * 64 + lane] = (bf16)f2bf(d[j] * r2);
                const float kp = lane < 32 ? bf2f(br[384 + lane]) : 0.f; const float s3 = wave_sum(kp * kp);
                const float kn = kp * (1.0f / sqrtf(s3 * (1.f / 32) + EPS)) * bkn[64 + (lane & 31)];
                const float other = __shfl_xor(kn, 16);
                const int pos = t & (SEQ - 1); const int fi = lane & 15;
                const float ang = (float)pos * powf(10000.0f, -((float)fi / 16.0f));
                float sn, cs; sincosf(ang, &sn, &cs);
                const float ro = (lane & 16) ? (kn * cs + other * sn) : (kn * cs - other * sn);
                if (lane < 32) KPE[(size_t)t * 32 + lane] = (bf16)f2bf(ro);
            }
            SEAM(PB + 3);
        }
        if (((MASK >> 4) & 1) && IN(PB + 4)) {
            naive_gemm((LAS float*)lds, CQN, 256, nullptr, T, p.in[I_BWQB] + (size_t)l * 256 * 384, 384, gain1(p.in[I_BQAN] + l * 256), 384, 256, QBRAW, 384, bid, G);
            __syncthreads();
            naive_gemm((LAS float*)lds, CKVN, 128, nullptr, T, p.in[I_BWKVB] + (size_t)l * 128 * 512, 512, gain1(p.in[I_BKVAN] + l * 128), 512, 128, KVBRAW, 512, bid, G);
            SEAM(PB + 4);
        }
        if (((MASK >> 5) & 1) && IN(PB + 5)) {
            const float* bqn = p.in[I_BQN] + l * 96; const float* bkn = p.in[I_BKN] + l * 96;
            for (int t = gw; t < T; t += NGW) {
                const int pos = t & (SEQ - 1);
                for (int h = 0; h < 4; ++h) {
                    const float* q = QBRAW + (size_t)t * 384 + h * 96;
                    const float v = q[lane]; const float ss = wave_sum(v * v);
                    QB[(size_t)t * 384 + h * 96 + lane] = (bf16)f2bf(v * (1.0f / sqrtf(ss * (1.f / 64) + EPS)) * bqn[lane] * QSCALE_B);
                    const float pe = lane < 32 ? q[64 + lane] : 0.f; const float s2 = wave_sum(pe * pe);
                    const float pn = pe * (1.0f / sqrtf(s2 * (1.f / 32) + EPS)) * bqn[64 + (lane & 31)];
                    const float other = __shfl_xor(pn, 16); const int fi = lane & 15;
                    const float ang = (float)pos * powf(10000.0f, -((float)fi / 16.0f)); float sn, cs; sincosf(ang, &sn, &cs);
                    const float ro = (lane & 16) ? (pn * cs + other * sn) : (pn * cs - other * sn);
                    if (lane < 32) QB[(size_t)t * 384 + h * 96 + 64 + lane] = (bf16)f2bf(ro * QSCALE_B);
                    const float* kv = KVBRAW + (size_t)t * 512 + h * 128;
                    const float kk = kv[lane]; const float s3 = wave_sum(kk * kk);
                    KBN[(size_t)t * 256 + h * 64 + lane] = (bf16)f2bf(kk * (1.0f / sqrtf(s3 * (1.f / 64) + EPS)) * bkn[lane]);
                    VB[(size_t)t * 256 + h * 64 + lane] = (bf16)f2bf(kv[64 + lane]);
                }
            }
            SEAM(PB + 5);
        }
        if (((MASK >> 6) & 1) && IN(PB + 6)) {
            const float* t5 = p.in[I_T5]; const float* sinks = p.in[I_ASINK] + l * 8; const float* crel = p.in[I_CREL] + (size_t)l * 320 * 4;
            for (int task0 = gw; task0 < 16 * 256; task0 += NGW) {
                const int task = __builtin_amdgcn_readfirstlane(task0);
                const int slot = task & 15, cidx = task >> 4, b = cidx >> 5, n = cidx & 31;
                const int t = b * SEQ + n * 64 + lane;
                const int kind = slot < 8 ? 0 : (slot < 12 ? 1 : 2);
                const int h = kind == 0 ? slot : (kind == 1 ? slot - 8 : slot - 12);
                const bf16* qrow = kind == 0 ? QA + (size_t)t * 512 + h * 64 : (kind == 1 ? QB + (size_t)t * 384 + h * 96 : QC + (size_t)t * 256 + h * 64);
                const bf16* kbase = kind == 0 ? KA + (h >> 2) * 64 : (kind == 1 ? KBN + h * 64 : KC + h * 64);
                const bf16* vbase = kind == 0 ? VA + (h >> 2) * 64 : (kind == 1 ? VB + h * 64 : VC + h * 64);
                const int kpitch = kind == 0 ? 128 : 256;
                const int nprev = kind == 0 ? 2 : (kind == 1 ? 32 : 8);
                unsigned qp[48]; float o[64];
#pragma unroll
                for (int i = 0; i < 64; ++i) o[i] = 0.f;
#pragma unroll
                for (int i = 0; i < 32; ++i) qp[i] = *(const unsigned*)(qrow + 2 * i);
#pragma unroll
                for (int i = 32; i < 48; ++i) qp[i] = kind == 1 ? *(const unsigned*)(qrow + 2 * i) : 0u;
                const float sink2 = kind == 0 ? sinks[h] * LOG2E : -1e30f;
                float m = sink2, lsum = 0.f;
                const int kc0 = n - nprev < 0 ? 0 : n - nprev;
                for (int kc = kc0; kc <= n; ++kc) for (int j = 0; j < 64; ++j) {
                    const size_t tk = (size_t)b * SEQ + kc * 64 + j;
                    const unsigned* kr = (const unsigned*)(kbase + tk * kpitch); const unsigned* vr = (const unsigned*)(vbase + tk * kpitch);
                    float s = 0.f;
#pragma unroll
                    for (int i = 0; i < 32; ++i) { const unsigned kw = kr[i]; s += bflo(qp[i]) * bflo(kw) + bfhi(qp[i]) * bfhi(kw); }
                    if (kind == 1) { const unsigned* pr = (const unsigned*)(KPE + tk * 32);
#pragma unroll
                        for (int i = 0; i < 16; ++i) { const unsigned kw = pr[i]; s += bflo(qp[32 + i]) * bflo(kw) + bfhi(qp[32 + i]) * bfhi(kw); } }
                    if (kind == 0) { const int rel = (kc * 64 + j) - (n * 64 + lane); s += t5[t5_bucket(rel) * 8 + h] * LOG2E; }
                    if (kind == 2) { int dist = (n * 64 + lane) - (kc * 64 + j); dist = dist < -63 ? -63 : (dist > 256 ? 256 : dist); s += crel[(dist + 63) * 4 + h] * LOG2E; }
                    if (s > m) { const float sc = exp2f(m - s); lsum *= sc;
#pragma unroll
                        for (int i = 0; i < 64; ++i) o[i] *= sc;
                        m = s; }
                    const float pj = exp2f(s - m); lsum += pj;
#pragma unroll
                    for (int i = 0; i < 32; ++i) { const unsigned vw = vr[i]; o[2 * i] += pj * bflo(vw); o[2 * i + 1] += pj * bfhi(vw); }
                }
                if (kind == 0) lsum += exp2f(sink2 - m);
                const float inv = 1.0f / lsum; float ss = 0.f;
                bf16* orow = OB + (size_t)t * D + slot * 64;
#pragma unroll
                for (int i = 0; i < 64; i += 2) { const float a = o[i] * inv, c = o[i + 1] * inv; ss += a * a + c * c; *(unsigned*)(orow + i) = pk2(a, c); }
                OSS[(size_t)t * 16 + slot] = ss;
            }
            SEAM(PB + 6);
        }
        if (((MASK >> 7) & 1) && IN(PB + 7)) {
            for (int t = gw; t < T; t += NGW) {
                const float sv = lane < 16 ? OSS[(size_t)t * 16 + lane] : 0.f;
                float sa = lane < 8 ? sv : 0.f, sb = (lane >= 8 && lane < 12) ? sv : 0.f, sc = (lane >= 12 && lane < 16) ? sv : 0.f;
                sa = wave_sum(sa); sb = wave_sum(sb); sc = wave_sum(sc);
                const float ra = 1.0f / sqrtf(sa * (1.f / 512) + EPS), rb = 1.0f / sqrtf(sb * (1.f / 256) + EPS), rc = 1.0f / sqrtf(sc * (1.f / 256) + EPS);
#pragma unroll
                for (int j = 0; j < 16; ++j) { const int c = j * 64 + lane; const float r = c < 512 ? ra : (c < 768 ? rb : rc);
                    ON[(size_t)t * D + c] = (bf16)f2bf(bf2f(OB[(size_t)t * D + c]) * r); }
            }
            SEAM(PB + 7);
        }
        if (((MASK >> 8) & 1) && IN(PB + 8)) {
            Gain g3; g3.g1 = p.in[I_AON] + l * 512; g3.g2 = p.in[I_BON] + l * 256; g3.g3 = p.in[I_CON] + l * 256; g3.s1 = 512; g3.s2 = 768;
            naive_gemm((LAS float*)lds, ON, D, nullptr, T, p.in[I_WOUT] + (size_t)l * D * D, D, g3, D, D, C2, D, bid, G);
            SEAM(PB + 8);
        }
        if (((MASK >> 9) & 1) && IN(PB + 9)) {
            for (int t = gw; t < T; t += NGW) {
                float ss = 0.f;
#pragma unroll
                for (int j = 0; j < 4; ++j) { const int c = 256 * j + 4 * lane;
                    f32x4 v = *(const f32x4*)(XRES + (size_t)t * D + c); const f32x4 a = *(const f32x4*)(C2 + (size_t)t * D + c); v = v + a;
                    ss += (v.x * v.x + v.y * v.y) + (v.z * v.z + v.w * v.w);
                    *(f32x4*)(XRES + (size_t)t * D + c) = v; uint2 o; o.x = pk2(v.x, v.y); o.y = pk2(v.z, v.w); *(uint2*)(XB + (size_t)t * D + c) = o; }
                ss = wave_sum(ss);
                if (lane < 16) SS1[(size_t)t * 16 + lane] = lane == 0 ? ss : 0.f;
            }
            SEAM(PB + 9);
        }
        if (((MASK >> 10) & 1) && IN(PB + 10)) {
            const float* wr = p.in[I_WR] + (size_t)l * D * NEXP; const float* br = p.in[I_BR] + l * NEXP; const float* fg = p.in[I_FFN_NORM] + l * D;
            LAS float* xs = (LAS float*)(lds) + wave * 1024;
            LAS int* pe = (LAS int*)(lds + 65536);
            LAS int* pbase = (LAS int*)(lds + 65536 + 1024);
            for (int tb = bid * 64; tb < T; tb += G * 64) {
                for (int i = 0; i < 8; ++i) {
                    const int t = tb + wave * 8 + i;
#pragma unroll
                    for (int j = 0; j < 4; ++j) { const int c = 256 * j + 4 * lane; const f32x4 v = *(const f32x4*)(XRES + (size_t)t * D + c); const f32x4 g = *(const f32x4*)(fg + c);
                        *(LAS f32x4*)(xs + c) = v * g; }
                    float sv = lane < 16 ? SS1[(size_t)t * 16 + lane] : 0.f; sv = wave_sum(sv);
                    const float rs = 1.0f / sqrtf(sv * (1.f / D) + EPS);
                    if (lane == 0) RSTD[t] = rs;
                    const int e = lane & 31, kh = lane >> 5; float acc = 0.f;
                    for (int k = kh * 512; k < kh * 512 + 512; ++k) acc += xs[k] * wr[(size_t)k * NEXP + e];
                    acc += __shfl_xor(acc, 32);
                    float logit = acc * rs + br[e];
                    float lv = logit; int ti[4]; float tv[4];
#pragma unroll
                    for (int r = 0; r < 4; ++r) {
                        float bv = lv; int bi = e;
#pragma unroll
                        for (int o = 1; o < 32; o <<= 1) { const float ov = __shfl_xor(bv, o); const int oi = __shfl_xor(bi, o); if (ov > bv || (ov == bv && oi < bi)) { bv = ov; bi = oi; } }
                        ti[r] = bi; tv[r] = bv; if (e == bi) lv = -3.0e38f;
                    }
                    const float e0 = 1.f, e1 = expf(tv[1] - tv[0]), e2 = expf(tv[2] - tv[0]), e3 = expf(tv[3] - tv[0]); const float inv = 1.0f / (e0 + e1 + e2 + e3);
                    if (lane == 0) { *(int4*)(TOPI + (size_t)t * 4) = make_int4(ti[0], ti[1], ti[2], ti[3]); *(f32x4*)(GATE + (size_t)t * 4) = (f32x4){e0 * inv, e1 * inv, e2 * inv, e3 * inv};
                        const int lp = (wave * 8 + i) * 4; pe[lp] = ti[0]; pe[lp + 1] = ti[1]; pe[lp + 2] = ti[2]; pe[lp + 3] = ti[3]; }
                }
                __syncthreads();
                if (tid < 32) { int c = 0; for (int i = 0; i < 256; ++i) c += (pe[i] == tid) ? 1 : 0;
                    const int base = (int)__hip_atomic_fetch_add(ctl + CW_CNT + (l * 32 + tid) * 64, (unsigned)c, __ATOMIC_RELAXED, __HIP_MEMORY_SCOPE_AGENT);
                    int k = 0; for (int i = 0; i < 256; ++i) if (pe[i] == tid) { LIST[(size_t)tid * LIST_CAP + base + k] = (tb + (i >> 2)) * 4 + (i & 3); ++k; } }
                __syncthreads();
            }
            SEAM(PB + 10);
        }
        if (((MASK >> 11) & 1) && IN(PB + 11)) {
            LAS int* tab = (LAS int*)(lds + 65536);
            load_exptab(tab, ctl, l);
            for (int e = 0; e < NEXP; ++e) {
                naive_gemm((LAS float*)lds, XB, D, LIST + (size_t)e * LIST_CAP, tab[e], p.in[I_WGU] + ((size_t)l * NEXP + e) * D * 2048, 2048, gain1(p.in[I_FFN_NORM] + l * D),
                           2048, D, SCR + (size_t)tab[32 + e] * 2048, 2048, bid, G);
            }
            SEAM(PB + 11);
        }
        if (((MASK >> 12) & 1) && IN(PB + 12)) {
            LAS int* tab = (LAS int*)(lds + 65536);
            load_exptab(tab, ctl, l);
            for (int e = 0; e < NEXP; ++e) {
                const float* bg = p.in[I_BGU] + ((size_t)l * NEXP + e) * 2048; const int cnt = tab[e], rb = tab[32 + e];
                for (int i = gw; i < cnt; i += NGW) {
                    const int pair = LIST[(size_t)e * LIST_CAP + i]; const float rs = RSTD[pair >> 2];
                    const float* hr = SCR + (size_t)(rb + i) * 2048; bf16* ar = ACT + (size_t)(rb + i) * D;
#pragma unroll
                    for (int j = 0; j < 16; ++j) { const int c = j * 64 + lane;
                        float gl = hr[c] * rs + bg[c], ln = hr[1024 + c] * rs + bg[1024 + c];
                        gl = fminf(gl, 7.0f); ln = fminf(fmaxf(ln, -7.0f), 7.0f);
                        const float a = gl * (1.0f / (1.0f + expf(-1.702f * gl))) * (ln + 1.0f);
                        ar[c] = (bf16)f2bf(a); }
                }
            }
            SEAM(PB + 12);
        }
        if (((MASK >> 13) & 1) && IN(PB + 13)) {
            LAS int* tab = (LAS int*)(lds + 65536);
            load_exptab(tab, ctl, l);
            for (int e = 0; e < NEXP; ++e) {
                naive_gemm((LAS float*)lds, ACT + (size_t)tab[32 + e] * D, D, nullptr, tab[e], p.in[I_WDN] + ((size_t)l * NEXP + e) * D * D, D, gain1(nullptr),
                           D, D, SCR + (size_t)tab[32 + e] * D, D, bid, G);
            }
            SEAM(PB + 13);
        }
        if (((MASK >> 14) & 1) && IN(PB + 14)) {
            LAS int* tab = (LAS int*)(lds + 65536);
            load_exptab(tab, ctl, l);
            for (int e = 0; e < NEXP; ++e) {
                const float* bd = p.in[I_BDN] + ((size_t)l * NEXP + e) * D; const int cnt = tab[e], rb = tab[32 + e];
                for (int i = gw; i < cnt; i += NGW) {
                    const int pair = LIST[(size_t)e * LIST_CAP + i]; const float g = GATE[pair];
                    const float* yr = SCR + (size_t)(rb + i) * D; bf16* yo = YB + (size_t)pair * D;
#pragma unroll
                    for (int j = 0; j < 16; ++j) { const int c = j * 64 + lane; yo[c] = (bf16)f2bf(g * (yr[c] + bd[c])); }
                }
            }
            SEAM(PB + 14);
        }
    }
#undef IN
#undef SEAM
}

template <unsigned MASK> static void launch_one(int grid, hipStream_t stream, const Params& p) {
    static bool attr_done = false;
    if (!attr_done) { (void)hipFuncSetAttribute((const void*)fwd<MASK>, hipFuncAttributeMaxDynamicSharedMemorySize, LDS_BYTES); attr_done = true; }
    hipLaunchKernelGGL(fwd<MASK>, dim3(grid), dim3(NTHREADS), LDS_BYTES, stream, p);
}
extern "C" void kernel_launch(void* const* d_in, const int* in_sizes, int n_in, void* d_out, int out_size, void* d_ws, size_t ws_size, hipStream_t stream) {
    static int grid = 0;
    if (grid == 0) {
        if (n_in != 27 || out_size != T * D || ws_size < WS_END) { fprintf(stderr, "kernel_launch: unexpected shapes: n_in %d out %d ws %zu\n", n_in, out_size, ws_size); grid = -1; return; }
        int dev = 0, cus = 0;
        if (hipGetDevice(&dev) != hipSuccess || hipDeviceGetAttribute(&cus, hipDeviceAttributeMultiprocessorCount, dev) != hipSuccess) { grid = -1; return; }
        grid = cus;
    }
    if (grid < 0) return;
    (void)hipMemsetAsync((char*)d_ws + WS_CTL, 0, CTL_ZERO_BYTES, stream);
    Params p{};
    for (int i = 0; i < 27; ++i) p.in[i] = (const float*)d_in[i];
    p.out = (float*)d_out; p.ws = (unsigned char*)d_ws;
    const int NPH = 1 + 16 * NLAYER + 1;
#if MK_ONE_LAUNCH
    p.ph_lo = 0; p.ph_hi = NPH;
    launch_one<0xFFFFu>(grid, stream, p);
#else
    for (int ph = 1; ph < NPH; ++ph) {
        const int s = (ph - 1) % 16; if (s == 15) continue;
        p.ph_lo = ph; p.ph_hi = ph + 1;
        switch (s) {
            case 0: launch_one<1u << 0>(grid, stream, p); break;   case 1: launch_one<1u << 1>(grid, stream, p); break;
            case 2: launch_one<1u << 2>(grid, stream, p); break;   case 3: launch_one<1u << 3>(grid, stream, p); break;
            case 4: launch_one<1u << 4>(grid, stream, p); break;   case 5: launch_one<1u << 5>(grid, stream, p); break;
            case 6: launch_one<1u << 6>(grid, stream, p); break;   case 7: launch_one<1u << 7>(grid, stream, p); break;
            case 8: launch_one<1u << 8>(grid, stream, p); break;   case 9: launch_one<1u << 9>(grid, stream, p); break;
            case 10: launch_one<1u << 10>(grid, stream, p); break; case 11: launch_one<1u << 11>(grid, stream, p); break;
            case 12: launch_one<1u << 12>(grid, stream, p); break; case 13: launch_one<1u << 13>(grid, stream, p); break;
            case 14: launch_one<1u << 14>(grid, stream, p); break;
        }
    }
#endif
}
```

```cpp
#include <hip/hip_runtime.h>
#include <cstdio>
#include <cstdint>

#ifndef MK_ONE_LAUNCH
#define MK_ONE_LAUNCH 0
#endif

#define GAS __attribute__((address_space(1)))
#define LAS __attribute__((address_space(3)))
typedef unsigned short bf16;
typedef float f32x4 __attribute__((ext_vector_type(4)));
typedef short bf16x8 __attribute__((ext_vector_type(8)));
typedef unsigned u32x4 __attribute__((ext_vector_type(4)));
typedef unsigned u32x2 __attribute__((ext_vector_type(2)));
typedef int i32x4 __attribute__((ext_vector_type(4)));

constexpr int T = 16384, SEQ = 2048, NBATCH = 8, D = 1024, NLAYER = 2, CHUNK = 64, NCH = 32;
constexpr int IN_W = 1952, NEXP = 32, TOPK = 4, DEXP = 1024;
constexpr float EPS = 1e-6f, LOG2E = 1.4426950408889634f;
constexpr float QSCALE_AC = 0.125f * LOG2E;
constexpr float QSCALE_B = 0.10206207261596575f * LOG2E;
constexpr int NROWS_MAX = (256 + 32) * 256;
constexpr int LIST_CAP = 16384;

constexpr size_t MiB = 1u << 20;
constexpr size_t WS_CTL = 0, CTL_ZERO_BYTES = 1 * MiB;
constexpr size_t WS_RSTD = 18 * MiB, WS_OSS = 19 * MiB, WS_SS1 = 20 * MiB, WS_TOPI = 21 * MiB, WS_GATE = 22 * MiB, WS_LIST = 24 * MiB;
constexpr size_t WS_XB = 32 * MiB, WS_QA = 64 * MiB, WS_KA = 80 * MiB, WS_VA = 84 * MiB, WS_QC = 88 * MiB, WS_KC = 96 * MiB, WS_VC = 104 * MiB;
constexpr size_t WS_BRAW = 112 * MiB, WS_QB = 128 * MiB, WS_KBN = 144 * MiB, WS_VB = 152 * MiB, WS_KPE = 160 * MiB, WS_O = 176 * MiB;
constexpr size_t WS_WIN = 2 * MiB, WS_WOUT = 10 * MiB;
constexpr size_t WS_WGU = 256 * MiB, WS_WDN = 512 * MiB;
constexpr size_t WS_ACT = 640 * MiB, WS_Y = 800 * MiB;
constexpr size_t WS_SCR = 1024 * MiB;
constexpr size_t WS_CQN = 1700 * MiB, WS_CKVN = 1708 * MiB, WS_QBRAW = 1712 * MiB, WS_KVBRAW = 1744 * MiB, WS_ON = 1784 * MiB, WS_C2 = 1816 * MiB, WS_END = 1880 * MiB;
constexpr int CW_BAR = 4096;
constexpr int CW_CNT = 16384;

constexpr int LDS_BYTES = 147456;
constexpr int NWAVES = 8, NTHREADS = 512;

__device__ __forceinline__ unsigned f2bf(float f) { unsigned u = __builtin_bit_cast(unsigned, f); return (u + 0x7fffu + ((u >> 16) & 1u)) >> 16; }
__device__ __forceinline__ unsigned pk2(float lo, float hi) { return f2bf(lo) | (f2bf(hi) << 16); }
__device__ __forceinline__ float bf2f(unsigned short b) { return __builtin_bit_cast(float, ((unsigned)b) << 16); }
__device__ __forceinline__ float bflo(unsigned w) { return __builtin_bit_cast(float, w << 16); }
__device__ __forceinline__ float bfhi(unsigned w) { return __builtin_bit_cast(float, w & 0xffff0000u); }
__device__ __forceinline__ float wave_sum(float v) {
#pragma unroll
    for (int o = 1; o < 64; o <<= 1) v += __shfl_xor(v, o);
    return v;
}
__device__ __forceinline__ int hidden_tid() { int t = threadIdx.x; asm volatile("" : "+v"(t)); return t; }
__device__ __forceinline__ unsigned ld_agent(const unsigned* p) { return __hip_atomic_load(p, __ATOMIC_RELAXED, __HIP_MEMORY_SCOPE_AGENT); }

#define XB_TMO      128
#define XB_XCNT(j)  (256  + 64 * (j))
#define XB_XSUB(j)  (1280 + 64 * (j))
#define XB_XGEN(j)  (2304 + 64 * (j))
#define XB_TOP      3328
#define XB_TOPGEN   3392
#define XCD_BAR_WORDS 3456
#define XB_SPIN_CAP (1u << 18)
__device__ __forceinline__ unsigned xb_ld(unsigned* p)              { return __hip_atomic_load(p, __ATOMIC_RELAXED, __HIP_MEMORY_SCOPE_AGENT); }
__device__ __forceinline__ unsigned xb_add(unsigned* p, unsigned v) { return __hip_atomic_fetch_add(p, v, __ATOMIC_RELAXED, __HIP_MEMORY_SCOPE_AGENT); }
__device__ __forceinline__ unsigned xb_xcc_id() { return (unsigned)__builtin_amdgcn_s_getreg((3 << 11) | 20) & 0xFu; }
#define XB_SPIN(cond, bar) do { unsigned _sp = 0; while (cond) { __builtin_amdgcn_s_sleep(1); \
    if ((++_sp & 255u) == 0u) { if (xb_ld(&(bar)[XB_TMO])) break; if (_sp > XB_SPIN_CAP) { atomicAdd(&(bar)[XB_TMO], 1u); break; } } } } while (0)
struct XcdBarrier { unsigned* bar; unsigned x; volatile LAS unsigned* st; };
__device__ __forceinline__ XcdBarrier xcd_barrier_post(unsigned* bar, volatile LAS unsigned* st) {
    XcdBarrier b; b.bar = bar; b.x = xb_xcc_id(); b.st = st;
    if (threadIdx.x == 0) (void)xb_add(&bar[XB_XCNT(b.x)], 1u);
    return b;
}
__device__ __forceinline__ void xcd_barrier_complete(unsigned* bar, unsigned x, unsigned& nloc, unsigned& nx) {
    const unsigned G = gridDim.x * gridDim.y * gridDim.z;
    unsigned sum, cnt, mine, sp = 0u;
    for (;;) {
        sum = 0u; cnt = 0u; mine = 0u;
#pragma unroll
        for (unsigned j = 0; j < 16; ++j) { const unsigned c = xb_ld(&bar[XB_XCNT(j)]); sum += c; cnt += (c > 0u) ? 1u : 0u; mine = (j == x) ? c : mine; }
        if (sum == G) break;
        __builtin_amdgcn_s_sleep(1);
        if ((++sp & 255u) == 0u) { if (xb_ld(&bar[XB_TMO])) break; if (sp > XB_SPIN_CAP) { atomicAdd(&bar[XB_TMO], 1u); break; } }
    }
    nloc = mine > 0u ? mine : 1u; nx = cnt > 0u ? cnt : 1u;
}
__device__ __forceinline__ void xcd_barrier(const XcdBarrier& b) {
    asm volatile("s_waitcnt vmcnt(0)" ::: "memory");
    __syncthreads();
    if (threadIdx.x == 0) {
        unsigned* bar = b.bar;
        __builtin_amdgcn_s_waitcnt(0);
        unsigned nloc = b.st[0], nx = b.st[1];
        if (nloc == 0u) { xcd_barrier_complete(bar, b.x, nloc, nx); b.st[0] = nloc; b.st[1] = nx; }
        const unsigned old = xb_add(&bar[XB_XSUB(b.x)], 1u);
        const unsigned gen = old / nloc;
        if (old + 1u == (gen + 1u) * nloc) {
            __builtin_amdgcn_fence(__ATOMIC_RELEASE, "agent");
            asm volatile("s_waitcnt vmcnt(0)" ::: "memory");
            const unsigned og = xb_add(&bar[XB_TOP], 1u);
            const unsigned tg = og / nx;
            if (og + 1u == (tg + 1u) * nx) xb_add(&bar[XB_TOPGEN], 1u);
            else XB_SPIN(xb_ld(&bar[XB_TOPGEN]) == tg, bar);
            __builtin_amdgcn_fence(__ATOMIC_ACQUIRE, "agent");
            xb_add(&bar[XB_XGEN(b.x)], 1u);
            asm volatile("s_waitcnt vmcnt(0)" ::: "memory");
        } else {
            XB_SPIN(xb_ld(&bar[XB_XGEN(b.x)]) == gen, bar);
            __builtin_amdgcn_fence(__ATOMIC_ACQUIRE, "agent");
            asm volatile("s_waitcnt vmcnt(0)" ::: "memory");
        }
    }
    __syncthreads();
}

struct Params { const float* in[27]; float* out; unsigned char* ws; int ph_lo, ph_hi; };
enum { I_X = 0, I_ATTN_NORM, I_W_IN, I_AQN, I_AKN, I_ASINK, I_T5, I_BQAN, I_BWQB, I_BKVAN, I_BWKVB, I_BQN, I_BKN, I_CQN, I_CKN, I_CREL,
       I_AON, I_BON, I_CON, I_WOUT, I_FFN_NORM, I_WR, I_BR, I_WGU, I_BGU, I_WDN, I_BDN };

struct Gain { const float* g1; const float* g2; const float* g3; int s1, s2;
    __device__ __forceinline__ float get(int k) const { return g1 == nullptr ? 1.f : (k < s1 ? g1[k] : (k < s2 ? g2[k - s1] : g3[k - s2])); } };
__device__ __forceinline__ Gain gain1(const float* g) { Gain r; r.g1 = g; r.g2 = g; r.g3 = g; r.s1 = 1 << 30; r.s2 = 1 << 30; return r; }
__device__ __forceinline__ void naive_gemm(LAS float* lds, const bf16* A, int lda, const int* rowmap, int M, const float* W, int ldw, const Gain gk,
                                           int N, int K, float* C, int ldc, int bid, int nb) {
    LAS float* As = lds;
    LAS float* Ws = lds + 32 * 68;
    const int tid = threadIdx.x, ty = tid >> 5, tx = tid & 31;
    const int ntm = (M + 63) / 64, ntn = (N + 127) / 128;
    for (int tile = bid; tile < ntm * ntn; tile += nb) {
        const int tm = tile / ntn, tn = tile % ntn, m0 = tm * 64, n0 = tn * 128;
        float acc[4][4];
#pragma unroll
        for (int i = 0; i < 4; ++i)
#pragma unroll
            for (int j = 0; j < 4; ++j) acc[i][j] = 0.f;
        for (int k0 = 0; k0 < K; k0 += 32) {
            { const int r = tid >> 3, kq = (tid & 7) * 4, m = m0 + r; float v[4] = {0.f, 0.f, 0.f, 0.f};
              if (m < M) { const int ar = rowmap ? (rowmap[m] >> 2) : m; const uint2 raw = *(const uint2*)(A + (size_t)ar * lda + k0 + kq);
                  v[0] = bflo(raw.x); v[1] = bfhi(raw.x); v[2] = bflo(raw.y); v[3] = bfhi(raw.y); }
#pragma unroll
              for (int i = 0; i < 4; ++i) As[(kq + i) * 68 + r] = v[i] * gk.get(k0 + kq + i); }
            { const int k = tid >> 4, nq = (tid & 15) * 8; const float* p = W + (size_t)(k0 + k) * ldw + n0 + nq;
#pragma unroll
              for (int j = 0; j < 8; ++j) Ws[k * 128 + nq + j] = (n0 + nq + j < N) ? p[j] : 0.f; }
            __syncthreads();
#pragma unroll 8
            for (int k = 0; k < 32; ++k) {
                const f32x4 a = *(const LAS f32x4*)(As + k * 68 + ty * 4), w = *(const LAS f32x4*)(Ws + k * 128 + tx * 4);
#pragma unroll
                for (int i = 0; i < 4; ++i)
#pragma unroll
                    for (int j = 0; j < 4; ++j) acc[i][j] += a[i] * w[j];
            }
            __syncthreads();
        }
#pragma unroll
        for (int i = 0; i < 4; ++i) { const int m = m0 + ty * 4 + i; if (m < M) {
#pragma unroll
            for (int j = 0; j < 4; ++j) { const int n = n0 + tx * 4 + j; if (n < N) C[(size_t)m * ldc + n] = acc[i][j]; } } }
    }
}

__device__ __forceinline__ int t5_bucket(int rel) {
    const int ret = rel > 0 ? 16 : 0; const int n = rel < 0 ? -rel : rel;
    if (n < 8) return ret + n;
    int large = 2 + (31 - __builtin_clz((unsigned)(n * n)));
    large = large > 15 ? 15 : large;
    return ret + large;
}

struct ExpTab { int cnt[32]; int rowbase[33]; };
__device__ __forceinline__ void load_exptab(LAS int* tab, const unsigned* ctl, int layer) {
    if (threadIdx.x < 32) tab[threadIdx.x] = (int)ld_agent(ctl + CW_CNT + (layer * 32 + threadIdx.x) * 64);
    __syncthreads();
    if (threadIdx.x == 0) { int rb = 0; for (int e = 0; e < 32; ++e) { tab[32 + e] = rb; rb += ((tab[e] + 255) / 256) * 256; } tab[64] = rb; }
    __syncthreads();
}


#ifndef FAST_G1
#define FAST_G1 1
#endif
#ifndef FAST_G2
#define FAST_G2 1
#endif
#ifndef FAST_MA
#define FAST_MA 1
#endif
#ifndef FAST_MB
#define FAST_MB 1
#endif
__device__ __forceinline__ int g1_colbase(int hh, int bj) {
    int base;
    if (hh < 8) base = hh * 64;
    else if (hh < 10) base = 512 + (hh - 8) * 64;
    else if (hh < 12) base = 640 + (hh - 10) * 64;
    else if (hh < 16) base = 1184 + (hh - 12) * 64;
    else if (hh < 20) base = 1440 + (hh - 16) * 64;
    else if (hh < 24) base = 1696 + (hh - 20) * 64;
    else if (hh < 28) base = 768 + (hh - 24) * 64;
    else if (hh < 30) base = 1024 + (hh - 28) * 64;
    else if (hh == 30) return bj == 0 ? 1152 : -1;
    else return -1;
    return base + 32 * bj;
}
__device__ __forceinline__ void cvt_item(LAS float* scr, const float* W, int ldw, int c0, const float* g1, const float* g2, const float* g3, int k0, bf16* dst, int lane) {
#pragma unroll
    for (int j = 0; j < 8; ++j) {
        const int kk = (lane >> 3) + 8 * j, cq = (lane & 7) * 4, k = k0 + kk;
        f32x4 v = (f32x4){0.f, 0.f, 0.f, 0.f};
        if (c0 >= 0) v = *(const f32x4*)(W + (size_t)k * ldw + c0 + cq);
        float gk = 1.f;
        if (g1) gk = g2 ? (k < 512 ? g1[k] : (k < 768 ? g2[k - 512] : g3[k - 768])) : g1[k];
        LAS float* d = scr + kk * 33 + cq; d[0] = v.x * gk; d[1] = v.y * gk; d[2] = v.z * gk; d[3] = v.w * gk;
    }
    asm volatile("s_waitcnt lgkmcnt(0)" ::: "memory");
    const int c = lane & 7;
#pragma unroll
    for (int j = 0; j < 4; ++j) {
        const int cc = (lane >> 3) + 8 * j; const LAS float* sp = scr + (8 * c) * 33 + cc;
        u32x4 o; o.x = pk2(sp[0], sp[33]); o.y = pk2(sp[66], sp[99]); o.z = pk2(sp[132], sp[165]); o.w = pk2(sp[198], sp[231]);
        const int slot = 16 * ((cc >> 2) & 1) + 4 * (cc >> 3) + (cc & 3);
        *(u32x4*)(dst + (size_t)slot * 1024 + k0 + 8 * c) = o;
    }
    asm volatile("s_waitcnt lgkmcnt(0)" ::: "memory");
}
__device__ __forceinline__ void p0_convert(LAS unsigned char* lds, const Params& p, int gw, int NGW, int wave, int lane) {
    LAS float* scr = (LAS float*)(lds + wave * 16384);
    unsigned char* ws = p.ws;
    constexpr int N_GU = 32 * 16 * 64, N_DN = 32 * 16 * 32, N_IN = 16 * 64, N_OUT = 16 * 32, N_L = N_GU + N_DN + N_IN + N_OUT;
    for (int it = gw; it < NLAYER * N_L; it += NGW) {
        const int l = it / N_L; int r = it - l * N_L;
        if (r < N_GU) { const int e = r >> 10, kb = (r >> 6) & 15, g = r & 63; const int pn = g >> 3, bj = (g >> 2) & 1, wc = g & 3;
            cvt_item(scr, p.in[I_WGU] + ((size_t)l * NEXP + e) * D * 2048, 2048, bj * 1024 + 128 * pn + 32 * wc, p.in[I_FFN_NORM] + l * D, nullptr, nullptr, kb * 64,
                     (bf16*)(ws + WS_WGU) + (((size_t)l * NEXP + e) * 2048 + 32 * g) * 1024, lane); continue; }
        r -= N_GU;
        if (r < N_DN) { const int e = r >> 9, kb = (r >> 5) & 15, g = r & 31;
            cvt_item(scr, p.in[I_WDN] + ((size_t)l * NEXP + e) * D * D, D, 32 * g, nullptr, nullptr, nullptr, kb * 64,
                     (bf16*)(ws + WS_WDN) + (((size_t)l * NEXP + e) * 1024 + 32 * g) * 1024, lane); continue; }
        r -= N_DN;
        if (r < N_IN) { const int kb = r >> 6, g = r & 63; const int pn = g >> 3, bj = (g >> 2) & 1, wc = g & 3;
            cvt_item(scr, p.in[I_W_IN] + (size_t)l * D * IN_W, IN_W, g1_colbase(pn * 4 + wc, bj), p.in[I_ATTN_NORM] + l * D, nullptr, nullptr, kb * 64,
                     (bf16*)(ws + WS_WIN) + ((size_t)l * 2048 + 32 * g) * 1024, lane); continue; }
        r -= N_IN;
        { const int kb = r >> 5, g = r & 31;
            cvt_item(scr, p.in[I_WOUT] + (size_t)l * D * D, D, 32 * g, p.in[I_AON] + l * 512, p.in[I_BON] + l * 256, p.in[I_CON] + l * 256, kb * 64,
                     (bf16*)(ws + WS_WOUT) + ((size_t)l * 1024 + 32 * g) * 1024, lane); }
    }
}

namespace fg {
constexpr int BK = 64, HALF = 128, HTB = HALF * BK * 2, STAGE_BYTES = 8 * HTB, KD = 1024, NT = KD / BK, NXCD = 8, WGM = 8;
constexpr int TAB_OFF = STAGE_BYTES, TAB_BYTES = 4096;
constexpr int EXPTAB_OFF = TAB_OFF + 2 * TAB_BYTES;
constexpr int ULIST_OFF = EXPTAB_OFF + 1024;
typedef f32x4 Acc[2][2][4][2];
__device__ __forceinline__ int lds_byte(int r, int c) { const int st = (r >> 4) * 2 + (c >> 5), rr = r & 15, cc = c & 31, ob = rr * 64 + cc * 2; return st * 1024 + (ob ^ (((ob >> 9) & 1) << 5)); }
__device__ __forceinline__ void stage_rc(int b, int& R, int& C) { const int st = b / 1024, sb = b % 1024, swz = sb ^ (((sb >> 9) & 1) << 5); R = (st >> 1) * 16 + swz / 64; C = (st & 1) * 32 + (swz % 64) / 2; }
__device__ __forceinline__ unsigned cvt_pk_bf16(float lo, float hi) { unsigned r; asm volatile("v_cvt_pk_bf16_f32 %0, %1, %2" : "=v"(r) : "v"(lo), "v"(hi)); return r; }
struct Unit { int a, b, c, d; };
struct StaticOrder {
    int nM, nN, nwg, G, c;
    __device__ void init(int M, int N, int G_, int c_) { nM = M / 256; nN = N / 256; nwg = nM * nN; G = G_; c = c_; }
    __device__ bool next(int i, Unit& u) const {
        const long L = (long)i * G + c; if (L >= nwg) return false;
        int wgid = (int)L; { const int q = nwg / NXCD, r = nwg % NXCD, xcd = wgid % NXCD, off = wgid / NXCD; wgid = (xcd < r ? xcd * (q + 1) : r * (q + 1) + (xcd - r) * q) + off; }
        const int nig = WGM * nN, gid = wgid / nig, fm = gid * WGM, gsz = (nM - fm) < WGM ? (nM - fm) : WGM;
        u.a = fm + ((wgid % nig) % gsz); u.b = (wgid % nig) / gsz; u.c = 0; u.d = 0; return true;
    }
};

template <class C>
__device__ __forceinline__ void gemm_phase(LAS unsigned char* lds, const C& cfg) {
    const int tid = threadIdx.x, wid = __builtin_amdgcn_readfirstlane(tid >> 6), lane = tid & 63, wr = wid >> 2, wc = wid & 3, fr = lane & 15, fq = lane >> 4;
    unsigned voffB[2], voffA[C::GATHER ? 4 : 2];
#pragma unroll
    for (int i = 0; i < 2; ++i) { int R, Cc; stage_rc(tid * 16 + i * 8192, R, Cc); voffB[i] = (unsigned)(R * KD + Cc) * 2u;
        if (!C::GATHER) voffA[i] = voffB[i]; }
#define FG_GATHER_OFFS(par) do { int tz = threadIdx.x; asm volatile("" : "+v"(tz)); _Pragma("unroll") for (int _i = 0; _i < 2; ++_i) { int R, Cc; stage_rc(tz * 16 + _i * 8192, R, Cc); \
        _Pragma("unroll") for (int _h = 0; _h < 2; ++_h) voffA[2 * _h + _i] = (unsigned)Cc * 2u + cfg.a_rowoff(par, _h * 128 + R, lds); } } while (0)
    const size_t kstep = (size_t)(BK * 2), hstep = (size_t)HALF * KD * 2;
    const unsigned ldsw = (unsigned)wid * 1024u;
    const int aoff = lds_byte(wr * 64 + fr, fq * 8), boff = lds_byte(wc * 32 + fr, fq * 8);
#define FG_SA(b, h) (((b) * 2 + (h)) * fg::HTB)
#define FG_SB(b, h) ((4 + (b) * 2 + (h)) * fg::HTB)
#define FG_STAGE(bufoff, gbase, voff) do { _Pragma("unroll") for (int _i = 0; _i < 2; ++_i) \
        __builtin_amdgcn_global_load_lds((const unsigned*)((const char*)(gbase) + (voff)[_i]), (LAS unsigned*)(lds + (bufoff) + ldsw + _i * 8192), 16, 0, 0); } while (0)
#define FG_STAGE_A(bufoff, gbase, h, vo) FG_STAGE(bufoff, (C::GATHER ? (gbase) : (gbase) + (h) * hstep), (C::GATHER ? (vo) + 2 * (h) : (vo)))
#define FG_LDA(dst, b, h) do { _Pragma("unroll") for (int m = 0; m < 4; ++m) _Pragma("unroll") for (int k = 0; k < 2; ++k) dst[m][k] = *(const LAS bf16x8*)(lds + FG_SA(b, h) + aoff + m * 2048 + k * 1024); } while (0)
#define FG_LDB(dst, b, h) do { _Pragma("unroll") for (int n = 0; n < 2; ++n) _Pragma("unroll") for (int k = 0; k < 2; ++k) dst[n][k] = *(const LAS bf16x8*)(lds + FG_SB(b, h) + boff + n * 2048 + k * 1024); } while (0)
#define FG_MMA(ai, bj, At, Bt) do { __builtin_amdgcn_s_setprio(1); _Pragma("unroll") for (int m = 0; m < 4; ++m) _Pragma("unroll") for (int n = 0; n < 2; ++n) _Pragma("unroll") for (int k = 0; k < 2; ++k) \
        acc[ai][bj][m][n] = __builtin_amdgcn_mfma_f32_16x16x32_bf16(Bt[n][k], At[m][k], acc[ai][bj][m][n], 0, 0, 0); __builtin_amdgcn_s_setprio(0); } while (0)
#define FG_WAIT_V(n) asm volatile("s_waitcnt vmcnt(" #n ")" ::: "memory")
#define FG_WAIT_L(n) asm volatile("s_waitcnt lgkmcnt(" #n ")" ::: "memory")
#define FG_BAR __builtin_amdgcn_s_barrier()
#define FG_SCHED __builtin_amdgcn_sched_barrier(0)
    Unit cur, nxt; int ui = 0;
    if (!cfg.next(0, cur)) return;
    Acc acc;
#pragma unroll
    for (int a = 0; a < 2; ++a)
#pragma unroll
        for (int b = 0; b < 2; ++b)
#pragma unroll
            for (int m = 0; m < 4; ++m)
#pragma unroll
                for (int n = 0; n < 2; ++n) acc[a][b][m][n] = (f32x4){0.f, 0.f, 0.f, 0.f};
    bf16x8 At[4][2], B0[2][2], B1[2][2];
    const char* cA = cfg.a_base(cur); const char* cB = cfg.b_base(cur);
    cfg.a_ready(cur, 0, lds);
    if (C::GATHER) FG_GATHER_OFFS(0);
    FG_STAGE(FG_SB(0, 0), cB, voffB); FG_STAGE(FG_SB(0, 1), cB + hstep, voffB); FG_STAGE_A(FG_SA(0, 0), cA, 0, voffA); FG_STAGE_A(FG_SA(0, 1), cA, 1, voffA);
    if (wr == 1) FG_BAR;
    FG_WAIT_V(2); FG_BAR;
    FG_STAGE(FG_SB(1, 0), cB + kstep, voffB); FG_STAGE_A(FG_SA(1, 0), cA + kstep, 0, voffA); FG_STAGE(FG_SB(1, 1), cB + hstep + kstep, voffB);
    FG_WAIT_V(6); FG_BAR;
    for (;;) {
        const bool has_next = cfg.next(ui + 1, nxt);
        const char* nA = has_next ? cfg.a_base(nxt) : cA; const char* nB = has_next ? cfg.b_base(nxt) : cB;
        for (int t = 0; t < NT; t += 2) {
            const bool last = (t == NT - 2);
            const char* a1 = cA + (size_t)(t + 1) * kstep;
            const char* a2 = last ? nA : cA + (size_t)(t + 2) * kstep; const char* b2 = last ? nB : cB + (size_t)(t + 2) * kstep;
            const char* a3 = a2 + kstep; const char* b3 = b2 + kstep;
            if (C::RESCALE) { if (t == 8 || t == 12) cfg.rescale(acc, t, ui & 1, wr, fr, lds); }
            FG_LDB(B0, 0, 0); FG_LDB(B1, 0, 1); FG_SCHED; FG_LDA(At, 0, 0); FG_STAGE_A(FG_SA(1, 1), a1, 1, voffA);
            FG_WAIT_V(8); FG_WAIT_L(0); FG_BAR; FG_MMA(0, 0, At, B0); FG_MMA(0, 1, At, B1); FG_BAR; FG_SCHED;
            if (last && has_next) { cfg.a_ready(nxt, (ui + 1) & 1, lds); if (C::GATHER) FG_GATHER_OFFS((ui + 1) & 1); }
            FG_LDA(At, 0, 1); FG_STAGE(FG_SB(0, 0), b2, voffB); FG_STAGE(FG_SB(0, 1), b2 + hstep, voffB); FG_STAGE_A(FG_SA(0, 0), a2, 0, voffA);
            FG_WAIT_V(8); FG_WAIT_L(0); FG_BAR; FG_MMA(1, 0, At, B0); FG_MMA(1, 1, At, B1); FG_BAR; FG_SCHED;
            FG_LDB(B0, 1, 0); FG_LDB(B1, 1, 1); FG_SCHED; FG_LDA(At, 1, 0); FG_STAGE_A(FG_SA(0, 1), a2, 1, voffA);
            FG_WAIT_V(8); FG_WAIT_L(0); FG_BAR; FG_MMA(0, 0, At, B0); FG_MMA(0, 1, At, B1); FG_BAR; FG_SCHED;
            FG_LDA(At, 1, 1); FG_STAGE(FG_SB(1, 0), b3, voffB); FG_STAGE(FG_SB(1, 1), b3 + hstep, voffB); FG_STAGE_A(FG_SA(1, 0), a3, 0, voffA);
            FG_WAIT_V(8); FG_WAIT_L(0); FG_BAR; FG_MMA(1, 0, At, B0); FG_MMA(1, 1, At, B1); FG_BAR; FG_SCHED;
        }
        if (wr == 0) FG_BAR;
        cfg.epi(acc, cur, ui & 1, wr, wc, fr, fq, lds);
        if (!has_next) break;
#pragma unroll
        for (int a = 0; a < 2; ++a)
#pragma unroll
            for (int b = 0; b < 2; ++b)
#pragma unroll
                for (int m = 0; m < 4; ++m)
#pragma unroll
                    for (int n = 0; n < 2; ++n) acc[a][b][m][n] = (f32x4){0.f, 0.f, 0.f, 0.f};
        cur = nxt; cA = nA; cB = nB; ++ui;
        if (wr == 1) FG_BAR;
    }
    FG_WAIT_V(0);
    FG_BAR;
}

struct CfgG1 {
    static constexpr bool GATHER = false, RESCALE = false;
    StaticOrder S; const bf16* A; const bf16* Bt; unsigned char* ws; const float* rstd;
    const float* aqn; const float* akn; const float* cqn; const float* ckn;
    __device__ __forceinline__ bool next(int i, Unit& u) const { return S.next(i, u); }
    __device__ __forceinline__ const char* a_base(const Unit& u) const { return (const char*)A + (size_t)u.a * 256 * KD * 2; }
    __device__ __forceinline__ const char* b_base(const Unit& u) const { return (const char*)Bt + (size_t)u.b * 256 * KD * 2; }
    __device__ __forceinline__ void a_ready(const Unit&, int, LAS unsigned char*) const {}
    __device__ __forceinline__ unsigned a_rowoff(int, int, LAS unsigned char*) const { return 0u; }
    __device__ __forceinline__ void rescale(Acc&, int, int, int, int, LAS unsigned char*) const {}
    __device__ __forceinline__ void epi(const Acc& acc, const Unit& u, int par, int wr, int wc, int fr, int fq, LAS unsigned char* lds) const {
        const int hh = u.b * 4 + wc;
        bf16* dst; int pitch; const float* gain = nullptr; float qs = 1.f;
        if (hh < 8) { dst = (bf16*)(ws + WS_QA) + hh * 64; pitch = 512; gain = aqn; qs = QSCALE_AC; }
        else if (hh < 10) { dst = (bf16*)(ws + WS_KA) + (hh - 8) * 64; pitch = 128; gain = akn; }
        else if (hh < 12) { dst = (bf16*)(ws + WS_VA) + (hh - 10) * 64; pitch = 128; }
        else if (hh < 16) { dst = (bf16*)(ws + WS_QC) + (hh - 12) * 64; pitch = 256; gain = cqn; qs = QSCALE_AC; }
        else if (hh < 20) { dst = (bf16*)(ws + WS_KC) + (hh - 16) * 64; pitch = 256; gain = ckn; }
        else if (hh < 24) { dst = (bf16*)(ws + WS_VC) + (hh - 20) * 64; pitch = 256; }
        else if (hh < 31) { dst = (bf16*)(ws + WS_BRAW) + (hh - 24) * 64; pitch = 512; }
        else return;
        f32x4 gv[2][2];
#pragma unroll
        for (int bj = 0; bj < 2; ++bj)
#pragma unroll
            for (int n = 0; n < 2; ++n) gv[bj][n] = gain ? *(const f32x4*)(gain + 32 * bj + 8 * fq + 4 * n) * qs : (f32x4){1.f, 1.f, 1.f, 1.f};
#pragma unroll
        for (int ai = 0; ai < 2; ++ai)
#pragma unroll
            for (int m = 0; m < 4; ++m) {
                const int row = u.a * 256 + ai * 128 + wr * 64 + m * 16 + fr;
                const float rs = rstd[row];
                f32x4 v[2][2]; float ss = 0.f;
#pragma unroll
                for (int bj = 0; bj < 2; ++bj)
#pragma unroll
                    for (int n = 0; n < 2; ++n) { v[bj][n] = acc[ai][bj][m][n] * rs; ss += (v[bj][n][0] * v[bj][n][0] + v[bj][n][1] * v[bj][n][1]) + (v[bj][n][2] * v[bj][n][2] + v[bj][n][3] * v[bj][n][3]); }
                float sc = 1.f;
                if (gain) { ss += __shfl_xor(ss, 16); ss += __shfl_xor(ss, 32); sc = 1.0f / sqrtf(ss * (1.f / 64) + EPS); }
                bf16* rowp = dst + (size_t)row * pitch + 8 * fq;
#pragma unroll
                for (int bj = 0; bj < 2; ++bj) { const f32x4 v0 = v[bj][0] * gv[bj][0] * sc, v1 = v[bj][1] * gv[bj][1] * sc;
                    u32x4 w; w.x = cvt_pk_bf16(v0[0], v0[1]); w.y = cvt_pk_bf16(v0[2], v0[3]); w.z = cvt_pk_bf16(v1[0], v1[1]); w.w = cvt_pk_bf16(v1[2], v1[3]);
                    *(u32x4*)(rowp + 32 * bj) = w; }
            }
    }
};

struct CfgG2 {
    static constexpr bool GATHER = false, RESCALE = true;
    StaticOrder S; const bf16* A; const bf16* Bt; unsigned char* ws; float* xres;
    __device__ __forceinline__ bool next(int i, Unit& u) const { return S.next(i, u); }
    __device__ __forceinline__ const char* a_base(const Unit& u) const { return (const char*)A + (size_t)u.a * 256 * KD * 2; }
    __device__ __forceinline__ const char* b_base(const Unit& u) const { return (const char*)Bt + (size_t)u.b * 256 * KD * 2; }
    __device__ __forceinline__ unsigned a_rowoff(int, int, LAS unsigned char*) const { return 0u; }
    __device__ __forceinline__ void a_ready(const Unit& u, int par, LAS unsigned char* lds) const {
        const int tx = hidden_tid();
        if (tx < 256) {
            const float* o = (const float*)(ws + WS_OSS) + (size_t)(u.a * 256 + tx) * 16;
            const f32x4 s0 = *(const f32x4*)o, s1 = *(const f32x4*)(o + 4), s2 = *(const f32x4*)(o + 8), s3 = *(const f32x4*)(o + 12);
            const float sa = (s0[0] + s0[1] + s0[2] + s0[3]) + (s1[0] + s1[1] + s1[2] + s1[3]), sb = s2[0] + s2[1] + s2[2] + s2[3], sc = s3[0] + s3[1] + s3[2] + s3[3];
            const float ra = 1.0f / sqrtf(sa * (1.f / 512) + EPS), rb = 1.0f / sqrtf(sb * (1.f / 256) + EPS), rc = 1.0f / sqrtf(sc * (1.f / 256) + EPS);
            *(LAS f32x4*)(lds + TAB_OFF + par * TAB_BYTES + tx * 16) = (f32x4){ra / rb, rb / rc, rc, 0.f};
        }
        asm volatile("s_waitcnt lgkmcnt(0)" ::: "memory"); __builtin_amdgcn_s_barrier(); asm volatile("" ::: "memory");
    }
    __device__ __forceinline__ void rescale(Acc& acc, int t, int par, int wr, int fr, LAS unsigned char* lds) const {
        const int which = (t == 8) ? 0 : 1;
#pragma unroll
        for (int ai = 0; ai < 2; ++ai)
#pragma unroll
            for (int m = 0; m < 4; ++m) { const int row = ai * 128 + wr * 64 + m * 16 + fr;
                const float f = *(const LAS float*)(lds + TAB_OFF + par * TAB_BYTES + row * 16 + which * 4);
#pragma unroll
                for (int bj = 0; bj < 2; ++bj)
#pragma unroll
                    for (int n = 0; n < 2; ++n) acc[ai][bj][m][n] = acc[ai][bj][m][n] * f; }
    }
    __device__ __forceinline__ void epi(const Acc& acc, const Unit& u, int par, int wr, int wc, int fr, int fq, LAS unsigned char* lds) const {
#pragma unroll
        for (int ai = 0; ai < 2; ++ai)
#pragma unroll
            for (int m = 0; m < 4; ++m) {
                const int rl = ai * 128 + wr * 64 + m * 16 + fr; const int row = u.a * 256 + rl;
                const float rc = *(const LAS float*)(lds + TAB_OFF + par * TAB_BYTES + rl * 16 + 8);
                float ss = 0.f;
#pragma unroll
                for (int bj = 0; bj < 2; ++bj) {
                    const size_t off = (size_t)row * D + u.b * 256 + bj * 128 + wc * 32 + 8 * fq;
                    f32x4 x0 = *(const f32x4*)(xres + off), x1 = *(const f32x4*)(xres + off + 4);
                    x0 = x0 + acc[ai][bj][m][0] * rc; x1 = x1 + acc[ai][bj][m][1] * rc;
                    ss += (x0[0] * x0[0] + x0[1] * x0[1]) + (x0[2] * x0[2] + x0[3] * x0[3]) + (x1[0] * x1[0] + x1[1] * x1[1]) + (x1[2] * x1[2] + x1[3] * x1[3]);
                    *(f32x4*)(xres + off) = x0; *(f32x4*)(xres + off + 4) = x1;
                    u32x4 w; w.x = cvt_pk_bf16(x0[0], x0[1]); w.y = cvt_pk_bf16(x0[2], x0[3]); w.z = cvt_pk_bf16(x1[0], x1[1]); w.w = cvt_pk_bf16(x1[2], x1[3]);
                    *(u32x4*)((bf16*)(ws + WS_XB) + off) = w;
                }
                ss += __shfl_xor(ss, 16); ss += __shfl_xor(ss, 32);
                if (fq == 0) ((float*)(ws + WS_SS1))[(size_t)row * 16 + u.b * 4 + wc] = ss;
            }
    }
};

__device__ __forceinline__ void build_exptab(LAS unsigned char* lds, const unsigned* ctl, int layer, int ntn, int G, int c) {
    LAS int* tab = (LAS int*)(lds + EXPTAB_OFF); const int tx = hidden_tid();
    if (tx < 32) tab[tx] = (int)ld_agent(ctl + CW_CNT + (layer * 32 + tx) * 64);
    __syncthreads();
    if (tx == 0) { int tb = 0; for (int e = 0; e < 32; ++e) { tab[32 + e] = tb * 256; tab[65 + e] = tb; tb += (tab[e] + 255) / 256; } tab[64] = tb * 256; tab[97] = tb; }
    __syncthreads();
    if (tx < 24) {
        const int L = tx * G + c, tg = L / ntn, pn = L % ntn; i32x4 ent = (i32x4){-1, 0, 0, 0};
        if (tg < tab[97]) { int e = 0; for (int k = 0; k < 32; ++k) e += (tg >= tab[65 + k + 1]) ? 1 : 0; ent = (i32x4){e, tg - tab[65 + e], pn, tab[32 + e] + (tg - tab[65 + e]) * 256}; }
        *(LAS i32x4*)(lds + ULIST_OFF + tx * 16) = ent;
    }
    __syncthreads();
}
struct CfgMA {
    static constexpr bool GATHER = true, RESCALE = false;
    unsigned char* ws; int layer; const float* bgu; LAS unsigned char* ldsb;
    __device__ __forceinline__ bool next(int i, Unit& u) const { if (i >= 24) return false; const i32x4 e = *(const LAS i32x4*)(ldsb + ULIST_OFF + i * 16);
        u.a = __builtin_amdgcn_readfirstlane(e.x); u.b = __builtin_amdgcn_readfirstlane(e.y); u.c = __builtin_amdgcn_readfirstlane(e.z); u.d = __builtin_amdgcn_readfirstlane(e.w); return u.a >= 0; }
    __device__ __forceinline__ const char* a_base(const Unit&) const { return (const char*)(ws + WS_XB); }
    __device__ __forceinline__ const char* b_base(const Unit& u) const { return (const char*)(ws + WS_WGU) + (((size_t)layer * NEXP + u.a) * 2048 + (size_t)u.c * 256) * KD * 2; }
    __device__ __forceinline__ void a_ready(const Unit& u, int par, LAS unsigned char* lds) const {
        const int tx = hidden_tid();
        if (tx < 256) {
            const LAS int* tab = (const LAS int*)(lds + EXPTAB_OFF); const int cnt = tab[u.a]; int i = u.b * 256 + tx; if (i >= cnt) i = 0;
            const int pair = ((const int*)(ws + WS_LIST))[(size_t)u.a * LIST_CAP + i]; const int tok = pair >> 2;
            *(LAS int*)(lds + TAB_OFF + par * TAB_BYTES + tx * 4) = tok;
            *(LAS float*)(lds + TAB_OFF + par * TAB_BYTES + 1024 + tx * 4) = ((const float*)(ws + WS_RSTD))[tok];
        }
        asm volatile("s_waitcnt lgkmcnt(0)" ::: "memory"); __builtin_amdgcn_s_barrier(); asm volatile("" ::: "memory");
    }
    __device__ __forceinline__ unsigned a_rowoff(int par, int row, LAS unsigned char* lds) const { return (unsigned)(*(const LAS int*)(lds + TAB_OFF + par * TAB_BYTES + row * 4)) * (unsigned)(KD * 2); }
    __device__ __forceinline__ void rescale(Acc&, int, int, int, int, LAS unsigned char*) const {}
    __device__ __forceinline__ void epi(const Acc& acc, const Unit& u, int par, int wr, int wc, int fr, int fq, LAS unsigned char* lds) const {
        const int j0 = 128 * u.c + 32 * wc + 8 * fq; const float* bg = bgu + (size_t)u.a * 2048;
        const f32x4 bgl0 = *(const f32x4*)(bg + j0), bgl1 = *(const f32x4*)(bg + j0 + 4), bli0 = *(const f32x4*)(bg + 1024 + j0), bli1 = *(const f32x4*)(bg + 1024 + j0 + 4);
        const int rbase = u.d;
        bf16* act = (bf16*)(ws + WS_ACT);
#pragma unroll
        for (int ai = 0; ai < 2; ++ai)
#pragma unroll
            for (int m = 0; m < 4; ++m) {
                const int rl = ai * 128 + wr * 64 + m * 16 + fr;
                const float rs = *(const LAS float*)(lds + TAB_OFF + par * TAB_BYTES + 1024 + rl * 4);
                f32x4 gl0 = acc[ai][0][m][0] * rs + bgl0, gl1 = acc[ai][0][m][1] * rs + bgl1, li0 = acc[ai][1][m][0] * rs + bli0, li1 = acc[ai][1][m][1] * rs + bli1;
                float a[8];
#pragma unroll
                for (int q = 0; q < 4; ++q) {
                    float g = fminf(gl0[q], 7.0f), lv = fminf(fmaxf(li0[q], -7.0f), 7.0f);
                    a[q] = g * __builtin_amdgcn_rcpf(1.0f + __builtin_amdgcn_exp2f(-1.702f * LOG2E * g)) * (lv + 1.0f);
                    g = fminf(gl1[q], 7.0f); lv = fminf(fmaxf(li1[q], -7.0f), 7.0f);
                    a[4 + q] = g * __builtin_amdgcn_rcpf(1.0f + __builtin_amdgcn_exp2f(-1.702f * LOG2E * g)) * (lv + 1.0f);
                }
                u32x4 w; w.x = cvt_pk_bf16(a[0], a[1]); w.y = cvt_pk_bf16(a[2], a[3]); w.z = cvt_pk_bf16(a[4], a[5]); w.w = cvt_pk_bf16(a[6], a[7]);
                *(u32x4*)(act + (size_t)(rbase + rl) * DEXP + j0) = w;
            }
    }
};
struct CfgMB {
    static constexpr bool GATHER = false, RESCALE = false;
    unsigned char* ws; int layer; const float* bdn; LAS unsigned char* ldsb;
    __device__ __forceinline__ bool next(int i, Unit& u) const { if (i >= 24) return false; const i32x4 e = *(const LAS i32x4*)(ldsb + ULIST_OFF + i * 16);
        u.a = __builtin_amdgcn_readfirstlane(e.x); u.b = __builtin_amdgcn_readfirstlane(e.y); u.c = __builtin_amdgcn_readfirstlane(e.z); u.d = __builtin_amdgcn_readfirstlane(e.w); return u.a >= 0; }
    __device__ __forceinline__ const char* a_base(const Unit& u) const { return (const char*)(ws + WS_ACT) + (size_t)u.d * KD * 2; }
    __device__ __forceinline__ const char* b_base(const Unit& u) const { return (const char*)(ws + WS_WDN) + (((size_t)layer * NEXP + u.a) * 1024 + (size_t)u.c * 256) * KD * 2; }
    __device__ __forceinline__ void a_ready(const Unit& u, int par, LAS unsigned char* lds) const {
        const int tx = hidden_tid();
        if (tx < 256) {
            const LAS int* tab = (const LAS int*)(lds + EXPTAB_OFF); const int cnt = tab[u.a]; const int i = u.b * 256 + tx;
            int pair = -1; float g = 0.f;
            if (i < cnt) { pair = ((const int*)(ws + WS_LIST))[(size_t)u.a * LIST_CAP + i]; g = ((const float*)(ws + WS_GATE))[pair]; }
            *(LAS int*)(lds + TAB_OFF + par * TAB_BYTES + tx * 4) = pair;
            *(LAS float*)(lds + TAB_OFF + par * TAB_BYTES + 1024 + tx * 4) = g;
        }
        asm volatile("s_waitcnt lgkmcnt(0)" ::: "memory"); __builtin_amdgcn_s_barrier(); asm volatile("" ::: "memory");
    }
    __device__ __forceinline__ unsigned a_rowoff(int, int, LAS unsigned char*) const { return 0u; }
    __device__ __forceinline__ void rescale(Acc&, int, int, int, int, LAS unsigned char*) const {}
    __device__ __forceinline__ void epi(const Acc& acc, const Unit& u, int par, int wr, int wc, int fr, int fq, LAS unsigned char* lds) const {
        const int c0 = 256 * u.c + 32 * wc + 8 * fq; const float* bd = bdn + (size_t)u.a * D;
        f32x4 bv[2][2];
#pragma unroll
        for (int bj = 0; bj < 2; ++bj) { bv[bj][0] = *(const f32x4*)(bd + c0 + 128 * bj); bv[bj][1] = *(const f32x4*)(bd + c0 + 128 * bj + 4); }
        bf16* yb = (bf16*)(ws + WS_Y);
#pragma unroll
        for (int ai = 0; ai < 2; ++ai)
#pragma unroll
            for (int m = 0; m < 4; ++m) {
                const int rl = ai * 128 + wr * 64 + m * 16 + fr;
                int pair = *(const LAS int*)(lds + TAB_OFF + par * TAB_BYTES + rl * 4);
                const float g = *(const LAS float*)(lds + TAB_OFF + par * TAB_BYTES + 1024 + rl * 4);
                pair = pair < 0 ? T * TOPK + rl : pair;
#pragma unroll
                for (int bj = 0; bj < 2; ++bj) { const f32x4 v0 = (acc[ai][bj][m][0] + bv[bj][0]) * g, v1 = (acc[ai][bj][m][1] + bv[bj][1]) * g;
                    u32x4 w; w.x = cvt_pk_bf16(v0[0], v0[1]); w.y = cvt_pk_bf16(v0[2], v0[3]); w.z = cvt_pk_bf16(v1[0], v1[1]); w.w = cvt_pk_bf16(v1[2], v1[3]);
                    *(u32x4*)(yb + (size_t)pair * D + c0 + 128 * bj) = w; }
            }
    }
};
}

template <unsigned MASK> __global__ void __launch_bounds__(NTHREADS, 2) fwd(Params p) {
    extern __shared__ __attribute__((aligned(16))) unsigned char lds_raw[];
    LAS unsigned char* lds = (LAS unsigned char*)lds_raw;
    const int tid = threadIdx.x, lane = tid & 63, wave = __builtin_amdgcn_readfirstlane(tid >> 6);
    const int G = gridDim.x, bid = blockIdx.x;
    const int gw = bid * NWAVES + wave, NGW = G * NWAVES;
    unsigned char* ws = p.ws;
    unsigned* ctl = (unsigned*)(ws + WS_CTL);
    volatile LAS unsigned* MISC = (volatile LAS unsigned*)(lds + LDS_BYTES - 128);
    if (tid < 32) MISC[tid] = 0u;
    __syncthreads();
    XcdBarrier bar; bar.bar = ctl + CW_BAR; bar.x = 0; bar.st = nullptr;
    if (MK_ONE_LAUNCH) bar = xcd_barrier_post(ctl + CW_BAR, MISC + 8);
    const int lo = p.ph_lo, hi = p.ph_hi;
#define IN(k) (lo <= (k) && (k) < hi)
#define SEAM(k) do { if (MK_ONE_LAUNCH && (k) + 1 < hi) xcd_barrier(bar); } while (0)

#define RSTD ((float*)(ws + WS_RSTD))
#define OSS ((float*)(ws + WS_OSS))
#define SS1 ((float*)(ws + WS_SS1))
#define TOPI ((int*)(ws + WS_TOPI))
#define GATE ((float*)(ws + WS_GATE))
#define LIST ((int*)(ws + WS_LIST))
#define XB ((bf16*)(ws + WS_XB))
#define QA ((bf16*)(ws + WS_QA))
#define KA ((bf16*)(ws + WS_KA))
#define VA ((bf16*)(ws + WS_VA))
#define QC ((bf16*)(ws + WS_QC))
#define KC ((bf16*)(ws + WS_KC))
#define VC ((bf16*)(ws + WS_VC))
#define BRAW ((bf16*)(ws + WS_BRAW))
#define QB ((bf16*)(ws + WS_QB))
#define KBN ((bf16*)(ws + WS_KBN))
#define VB ((bf16*)(ws + WS_VB))
#define KPE ((bf16*)(ws + WS_KPE))
#define OB ((bf16*)(ws + WS_O))
#define ACT ((bf16*)(ws + WS_ACT))
#define YB ((bf16*)(ws + WS_Y))
#define SCR ((float*)(ws + WS_SCR))
#define CQN ((bf16*)(ws + WS_CQN))
#define CKVN ((bf16*)(ws + WS_CKVN))
#define QBRAW ((float*)(ws + WS_QBRAW))
#define KVBRAW ((float*)(ws + WS_KVBRAW))
#define ON ((bf16*)(ws + WS_ON))
#define C2 ((float*)(ws + WS_C2))
    float* XRES = p.out;

    if (((MASK >> 15) & 1) && IN(0)) {
        p0_convert(lds, p, gw, NGW, wave, lane);
        SEAM(0);
    }
    for (int l = 0; l < NLAYER + 1; ++l) {
        const int PB = 1 + 16 * l;
        if (((MASK >> 0) & 1) && IN(PB + 0)) {
            const float* xin = p.in[I_X];
            for (int t = gw; t < T; t += NGW) {
                f32x4 v[4]; float ss = 0.f;
#pragma unroll
                for (int j = 0; j < 4; ++j) {
                    const int c = 256 * j + 4 * lane;
                    if (l == 0) v[j] = *(const f32x4*)(xin + (size_t)t * D + c);
                    else { v[j] = *(const f32x4*)(XRES + (size_t)t * D + c);
#pragma unroll
                        for (int k = 0; k < 4; ++k) { const uint2 y = *(const uint2*)(YB + ((size_t)t * 4 + k) * D + c);
                            v[j].x += bflo(y.x); v[j].y += bfhi(y.x); v[j].z += bflo(y.y); v[j].w += bfhi(y.y); } }
                    ss += (v[j].x * v[j].x + v[j].y * v[j].y) + (v[j].z * v[j].z + v[j].w * v[j].w);
                    *(f32x4*)(XRES + (size_t)t * D + c) = v[j];
                    if (l < NLAYER) { uint2 o; o.x = pk2(v[j].x, v[j].y); o.y = pk2(v[j].z, v[j].w); *(uint2*)(XB + (size_t)t * D + c) = o; }
                }
                ss = wave_sum(ss);
                if (lane == 0 && l < NLAYER) RSTD[t] = 1.0f / sqrtf(ss * (1.0f / D) + EPS);
            }
            SEAM(PB + 0);
        }
        if (l == NLAYER) break;
        if (((MASK >> 1) & 1) && IN(PB + 1)) {
#if FAST_G1
            fg::CfgG1 cfg; cfg.S.init(T, 2048, G, bid); cfg.A = XB; cfg.Bt = (const bf16*)(ws + WS_WIN) + (size_t)l * 2048 * 1024; cfg.ws = ws; cfg.rstd = RSTD;
            cfg.aqn = p.in[I_AQN] + l * 64; cfg.akn = p.in[I_AKN] + l * 64; cfg.cqn = p.in[I_CQN] + l * 64; cfg.ckn = p.in[I_CKN] + l * 64;
            fg::gemm_phase(lds, cfg);
#else
            naive_gemm((LAS float*)lds, XB, D, nullptr, T, p.in[I_W_IN] + (size_t)l * D * IN_W, IN_W, gain1(p.in[I_ATTN_NORM] + l * D), IN_W, D, SCR, IN_W, bid, G);
#endif
            SEAM(PB + 1);
        }
        if (!FAST_G1 && ((MASK >> 2) & 1) && IN(PB + 2)) {
            const float* aqn = p.in[I_AQN] + l * 64; const float* akn = p.in[I_AKN] + l * 64; const float* cqn = p.in[I_CQN] + l * 64; const float* ckn = p.in[I_CKN] + l * 64;
            for (int t = gw; t < T; t += NGW) {
                const float rs = RSTD[t]; const float* pr = SCR + (size_t)t * IN_W;
                for (int h = 0; h < 8; ++h) { const float v = pr[h * 64 + lane] * rs; const float ss = wave_sum(v * v);
                    QA[(size_t)t * 512 + h * 64 + lane] = (bf16)f2bf(v * (1.0f / sqrtf(ss * (1.f / 64) + EPS)) * aqn[lane] * QSCALE_AC); }
                for (int h = 0; h < 2; ++h) { const float v = pr[512 + h * 64 + lane] * rs; const float ss = wave_sum(v * v);
                    KA[(size_t)t * 128 + h * 64 + lane] = (bf16)f2bf(v * (1.0f / sqrtf(ss * (1.f / 64) + EPS)) * akn[lane]); }
                for (int h = 0; h < 2; ++h) VA[(size_t)t * 128 + h * 64 + lane] = (bf16)f2bf(pr[640 + h * 64 + lane] * rs);
                for (int j = 0; j < 7; ++j) { const int c = j * 64 + lane; if (c < 416) BRAW[(size_t)t * 512 + c] = (bf16)f2bf(pr[768 + c] * rs); }
                for (int h = 0; h < 4; ++h) { const float v = pr[1184 + h * 64 + lane] * rs; const float ss = wave_sum(v * v);
                    QC[(size_t)t * 256 + h * 64 + lane] = (bf16)f2bf(v * (1.0f / sqrtf(ss * (1.f / 64) + EPS)) * cqn[lane] * QSCALE_AC); }
                for (int h = 0; h < 4; ++h) { const float v = pr[1440 + h * 64 + lane] * rs; const float ss = wave_sum(v * v);
                    KC[(size_t)t * 256 + h * 64 + lane] = (bf16)f2bf(v * (1.0f / sqrtf(ss * (1.f / 64) + EPS)) * ckn[lane]); }
                for (int h = 0; h < 4; ++h) VC[(size_t)t * 256 + h * 64 + lane] = (bf16)f2bf(pr[1696 + h * 64 + lane] * rs);
            }
            SEAM(PB + 2);
        }
        if (((MASK >> 3) & 1) && IN(PB + 3)) {
            const float* bkn = p.in[I_BKN] + l * 96;
            for (int t = gw; t < T; t += NGW) {
                const bf16* br = BRAW + (size_t)t * 512;
                float c[4]; float ss = 0.f;
#pragma unroll
                for (int j = 0; j < 4; ++j) { c[j] = bf2f(br[j * 64 + lane]); ss += c[j] * c[j]; }
                ss = wave_sum(ss); const float r1 = 1.0f / sqrtf(ss * (1.f / 256) + EPS);
#pragma unroll
                for (int j = 0; j < 4; ++j) CQN[(size_t)t * 256 + j * 64 + lane] = (bf16)f2bf(c[j] * r1);
                float d[2]; float s2 = 0.f;
#pragma unroll
                for (int j = 0; j < 2; ++j) { d[j] = bf2f(br[256 + j * 64 + lane]); s2 += d[j] * d[j]; }
                s2 = wave_sum(s2); const float r2 = 1.0f / sqrtf(s2 * (1.f / 128) + EPS);
#pragma unroll
                for (int j = 0; j < 2; ++j) CKVN[(size_t)t * 128 + j * 64 + lane] = (bf16)f2bf(d[j] * r2);
                const float kp = lane < 32 ? bf2f(br[384 + lane]) : 0.f; const float s3 = wave_sum(kp * kp);
                const float kn = kp * (1.0f / sqrtf(s3 * (1.f / 32) + EPS)) * bkn[64 + (lane & 31)];
                const float other = __shfl_xor(kn, 16);
                const int pos = t & (SEQ - 1); const int fi = lane & 15;
                const float ang = (float)pos * powf(10000.0f, -((float)fi / 16.0f));
                float sn, cs; sincosf(ang, &sn, &cs);
                const float ro = (lane & 16) ? (kn * cs + other * sn) : (kn * cs - other * sn);
                if (lane < 32) KPE[(size_t)t * 32 + lane] = (bf16)f2bf(ro);
            }
            SEAM(PB + 3);
        }
        if (((MASK >> 4) & 1) && IN(PB + 4)) {
            naive_gemm((LAS float*)lds, CQN, 256, nullptr, T, p.in[I_BWQB] + (size_t)l * 256 * 384, 384, gain1(p.in[I_BQAN] + l * 256), 384, 256, QBRAW, 384, bid, G);
            __syncthreads();
            naive_gemm((LAS float*)lds, CKVN, 128, nullptr, T, p.in[I_BWKVB] + (size_t)l * 128 * 512, 512, gain1(p.in[I_BKVAN] + l * 128), 512, 128, KVBRAW, 512, bid, G);
            SEAM(PB + 4);
        }
        if (((MASK >> 5) & 1) && IN(PB + 5)) {
            const float* bqn = p.in[I_BQN] + l * 96; const float* bkn = p.in[I_BKN] + l * 96;
            for (int t = gw; t < T; t += NGW) {
                const int pos = t & (SEQ - 1);
                for (int h = 0; h < 4; ++h) {
                    const float* q = QBRAW + (size_t)t * 384 + h * 96;
                    const float v = q[lane]; const float ss = wave_sum(v * v);
                    QB[(size_t)t * 384 + h * 96 + lane] = (bf16)f2bf(v * (1.0f / sqrtf(ss * (1.f / 64) + EPS)) * bqn[lane] * QSCALE_B);
                    const float pe = lane < 32 ? q[64 + lane] : 0.f; const float s2 = wave_sum(pe * pe);
                    const float pn = pe * (1.0f / sqrtf(s2 * (1.f / 32) + EPS)) * bqn[64 + (lane & 31)];
                    const float other = __shfl_xor(pn, 16); const int fi = lane & 15;
                    const float ang = (float)pos * powf(10000.0f, -((float)fi / 16.0f)); float sn, cs; sincosf(ang, &sn, &cs);
                    const float ro = (lane & 16) ? (pn * cs + other * sn) : (pn * cs - other * sn);
                    if (lane < 32) QB[(size_t)t * 384 + h * 96 + 64 + lane] = (bf16)f2bf(ro * QSCALE_B);
                    const float* kv = KVBRAW + (size_t)t * 512 + h * 128;
                    const float kk = kv[lane]; const float s3 = wave_sum(kk * kk);
                    KBN[(size_t)t * 256 + h * 64 + lane] = (bf16)f2bf(kk * (1.0f / sqrtf(s3 * (1.f / 64) + EPS)) * bkn[lane]);
                    VB[(size_t)t * 256 + h * 64 + lane] = (bf16)f2bf(kv[64 + lane]);
                }
            }
            SEAM(PB + 5);
        }
        if (((MASK >> 6) & 1) && IN(PB + 6)) {
            const float* t5 = p.in[I_T5]; const float* sinks = p.in[I_ASINK] + l * 8; const float* crel = p.in[I_CREL] + (size_t)l * 320 * 4;
            for (int task0 = gw; task0 < 16 * 256; task0 += NGW) {
                const int task = __builtin_amdgcn_readfirstlane(task0);
                const int slot = task & 15, cidx = task >> 4, b = cidx >> 5, n = cidx & 31;
                const int t = b * SEQ + n * 64 + lane;
                const int kind = slot < 8 ? 0 : (slot < 12 ? 1 : 2);
                const int h = kind == 0 ? slot : (kind == 1 ? slot - 8 : slot - 12);
                const bf16* qrow = kind == 0 ? QA + (size_t)t * 512 + h * 64 : (kind == 1 ? QB + (size_t)t * 384 + h * 96 : QC + (size_t)t * 256 + h * 64);
                const bf16* kbase = kind == 0 ? KA + (h >> 2) * 64 : (kind == 1 ? KBN + h * 64 : KC + h * 64);
                const bf16* vbase = kind == 0 ? VA + (h >> 2) * 64 : (kind == 1 ? VB + h * 64 : VC + h * 64);
                const int kpitch = kind == 0 ? 128 : 256;
                const int nprev = kind == 0 ? 2 : (kind == 1 ? 32 : 8);
                unsigned qp[48];
#pragma unroll
                for (int i = 0; i < 32; ++i) qp[i] = *(const unsigned*)(qrow + 2 * i);
#pragma unroll
                for (int i = 32; i < 48; ++i) qp[i] = kind == 1 ? *(const unsigned*)(qrow + 2 * i) : 0u;
                const float sink2 = kind == 0 ? sinks[h] * LOG2E : -1e30f;
                const int kc0 = n - nprev < 0 ? 0 : n - nprev;
                float ss = 0.f;
                bf16* orow = OB + (size_t)t * D + slot * 64;
                for (int half = 0; half < 2; ++half) {
                    float o[32];
#pragma unroll
                    for (int i = 0; i < 32; ++i) o[i] = 0.f;
                    float m = sink2, lsum = 0.f;
                    for (int kc = kc0; kc <= n; ++kc) for (int j = 0; j < 64; ++j) {
                        const size_t tk = (size_t)b * SEQ + kc * 64 + j;
                        const unsigned* kr = (const unsigned*)(kbase + tk * kpitch); const unsigned* vr = (const unsigned*)(vbase + tk * kpitch) + half * 16;
                        float s = 0.f;
#pragma unroll
                        for (int i = 0; i < 32; ++i) { const unsigned kw = kr[i]; s += bflo(qp[i]) * bflo(kw) + bfhi(qp[i]) * bfhi(kw); }
                        if (kind == 1) { const unsigned* pr = (const unsigned*)(KPE + tk * 32);
#pragma unroll
                            for (int i = 0; i < 16; ++i) { const unsigned kw = pr[i]; s += bflo(qp[32 + i]) * bflo(kw) + bfhi(qp[32 + i]) * bfhi(kw); } }
                        if (kind == 0) { const int rel = (kc * 64 + j) - (n * 64 + lane); s += t5[t5_bucket(rel) * 8 + h] * LOG2E; }
                        if (kind == 2) { int dist = (n * 64 + lane) - (kc * 64 + j); dist = dist < -63 ? -63 : (dist > 256 ? 256 : dist); s += crel[(dist + 63) * 4 + h] * LOG2E; }
                        if (s > m) { const float sc = exp2f(m - s); lsum *= sc;
#pragma unroll
                            for (int i = 0; i < 32; ++i) o[i] *= sc;
                            m = s; }
                        const float pj = exp2f(s - m); lsum += pj;
#pragma unroll
                        for (int i = 0; i < 16; ++i) { const unsigned vw = vr[i]; o[2 * i] += pj * bflo(vw); o[2 * i + 1] += pj * bfhi(vw); }
                    }
                    if (kind == 0) lsum += exp2f(sink2 - m);
                    const float inv = 1.0f / lsum;
#pragma unroll
                    for (int i = 0; i < 32; i += 2) { const float a = o[i] * inv, c = o[i + 1] * inv; ss += a * a + c * c; *(unsigned*)(orow + half * 32 + i) = pk2(a, c); }
                }
                OSS[(size_t)t * 16 + slot] = ss;
            }
            SEAM(PB + 6);
        }
        if (!FAST_G2 && ((MASK >> 7) & 1) && IN(PB + 7)) {
            for (int t = gw; t < T; t += NGW) {
                const float sv = lane < 16 ? OSS[(size_t)t * 16 + lane] : 0.f;
                float sa = lane < 8 ? sv : 0.f, sb = (lane >= 8 && lane < 12) ? sv : 0.f, sc = (lane >= 12 && lane < 16) ? sv : 0.f;
                sa = wave_sum(sa); sb = wave_sum(sb); sc = wave_sum(sc);
                const float ra = 1.0f / sqrtf(sa * (1.f / 512) + EPS), rb = 1.0f / sqrtf(sb * (1.f / 256) + EPS), rc = 1.0f / sqrtf(sc * (1.f / 256) + EPS);
#pragma unroll
                for (int j = 0; j < 16; ++j) { const int c = j * 64 + lane; const float r = c < 512 ? ra : (c < 768 ? rb : rc);
                    ON[(size_t)t * D + c] = (bf16)f2bf(bf2f(OB[(size_t)t * D + c]) * r); }
            }
            SEAM(PB + 7);
        }
        if (((MASK >> 8) & 1) && IN(PB + 8)) {
#if FAST_G2
            fg::CfgG2 cfg; cfg.S.init(T, 1024, G, bid); cfg.A = OB; cfg.Bt = (const bf16*)(ws + WS_WOUT) + (size_t)l * 1024 * 1024; cfg.ws = ws; cfg.xres = XRES;
            fg::gemm_phase(lds, cfg);
#else
            Gain g3; g3.g1 = p.in[I_AON] + l * 512; g3.g2 = p.in[I_BON] + l * 256; g3.g3 = p.in[I_CON] + l * 256; g3.s1 = 512; g3.s2 = 768;
            naive_gemm((LAS float*)lds, ON, D, nullptr, T, p.in[I_WOUT] + (size_t)l * D * D, D, g3, D, D, C2, D, bid, G);
#endif
            SEAM(PB + 8);
        }
        if (!FAST_G2 && ((MASK >> 9) & 1) && IN(PB + 9)) {
            for (int t = gw; t < T; t += NGW) {
                float ss = 0.f;
#pragma unroll
                for (int j = 0; j < 4; ++j) { const int c = 256 * j + 4 * lane;
                    f32x4 v = *(const f32x4*)(XRES + (size_t)t * D + c); const f32x4 a = *(const f32x4*)(C2 + (size_t)t * D + c); v = v + a;
                    ss += (v.x * v.x + v.y * v.y) + (v.z * v.z + v.w * v.w);
                    *(f32x4*)(XRES + (size_t)t * D + c) = v; uint2 o; o.x = pk2(v.x, v.y); o.y = pk2(v.z, v.w); *(uint2*)(XB + (size_t)t * D + c) = o; }
                ss = wave_sum(ss);
                if (lane < 16) SS1[(size_t)t * 16 + lane] = lane == 0 ? ss : 0.f;
            }
            SEAM(PB + 9);
        }
        if (((MASK >> 10) & 1) && IN(PB + 10)) {
            const float* wr = p.in[I_WR] + (size_t)l * D * NEXP; const float* br = p.in[I_BR] + l * NEXP; const float* fg = p.in[I_FFN_NORM] + l * D;
            LAS float* xs = (LAS float*)(lds) + wave * 1024;
            LAS int* pe = (LAS int*)(lds + 65536);
            LAS int* pbase = (LAS int*)(lds + 65536 + 1024);
            for (int tb = bid * 64; tb < T; tb += G * 64) {
                for (int i = 0; i < 8; ++i) {
                    const int t = tb + wave * 8 + i;
#pragma unroll
                    for (int j = 0; j < 4; ++j) { const int c = 256 * j + 4 * lane; const f32x4 v = *(const f32x4*)(XRES + (size_t)t * D + c); const f32x4 g = *(const f32x4*)(fg + c);
                        *(LAS f32x4*)(xs + c) = v * g; }
                    float sv = lane < 16 ? SS1[(size_t)t * 16 + lane] : 0.f; sv = wave_sum(sv);
                    const float rs = 1.0f / sqrtf(sv * (1.f / D) + EPS);
                    if (lane == 0) RSTD[t] = rs;
                    const int e = lane & 31, kh = lane >> 5; float acc = 0.f;
                    for (int k = kh * 512; k < kh * 512 + 512; ++k) acc += xs[k] * wr[(size_t)k * NEXP + e];
                    acc += __shfl_xor(acc, 32);
                    float logit = acc * rs + br[e];
                    float lv = logit; int ti[4]; float tv[4];
#pragma unroll
                    for (int r = 0; r < 4; ++r) {
                        float bv = lv; int bi = e;
#pragma unroll
                        for (int o = 1; o < 32; o <<= 1) { const float ov = __shfl_xor(bv, o); const int oi = __shfl_xor(bi, o); if (ov > bv || (ov == bv && oi < bi)) { bv = ov; bi = oi; } }
                        ti[r] = bi; tv[r] = bv; if (e == bi) lv = -3.0e38f;
                    }
                    const float e0 = 1.f, e1 = expf(tv[1] - tv[0]), e2 = expf(tv[2] - tv[0]), e3 = expf(tv[3] - tv[0]); const float inv = 1.0f / (e0 + e1 + e2 + e3);
                    if (lane == 0) { *(int4*)(TOPI + (size_t)t * 4) = make_int4(ti[0], ti[1], ti[2], ti[3]); *(f32x4*)(GATE + (size_t)t * 4) = (f32x4){e0 * inv, e1 * inv, e2 * inv, e3 * inv};
                        const int lp = (wave * 8 + i) * 4; pe[lp] = ti[0]; pe[lp + 1] = ti[1]; pe[lp + 2] = ti[2]; pe[lp + 3] = ti[3]; }
                }
                __syncthreads();
                if (tid < 32) { int c = 0; for (int i = 0; i < 256; ++i) c += (pe[i] == tid) ? 1 : 0;
                    const int base = (int)__hip_atomic_fetch_add(ctl + CW_CNT + (l * 32 + tid) * 64, (unsigned)c, __ATOMIC_RELAXED, __HIP_MEMORY_SCOPE_AGENT);
                    int k = 0; for (int i = 0; i < 256; ++i) if (pe[i] == tid) { LIST[(size_t)tid * LIST_CAP + base + k] = (tb + (i >> 2)) * 4 + (i & 3); ++k; } }
                __syncthreads();
            }
            SEAM(PB + 10);
        }
        if (((MASK >> 11) & 1) && IN(PB + 11)) {
#if FAST_MA
            fg::build_exptab(lds, ctl, l, 8, G, bid);
            fg::CfgMA cfg; cfg.ws = ws; cfg.layer = l; cfg.bgu = p.in[I_BGU] + (size_t)l * NEXP * 2048; cfg.ldsb = lds;
            fg::gemm_phase(lds, cfg);
#else
            LAS int* tab = (LAS int*)(lds + 65536);
            load_exptab(tab, ctl, l);
            for (int e = 0; e < NEXP; ++e) {
                naive_gemm((LAS float*)lds, XB, D, LIST + (size_t)e * LIST_CAP, tab[e], p.in[I_WGU] + ((size_t)l * NEXP + e) * D * 2048, 2048, gain1(p.in[I_FFN_NORM] + l * D),
                           2048, D, SCR + (size_t)tab[32 + e] * 2048, 2048, bid, G);
            }
#endif
            SEAM(PB + 11);
        }
        if (!FAST_MA && ((MASK >> 12) & 1) && IN(PB + 12)) {
            LAS int* tab = (LAS int*)(lds + 65536);
            load_exptab(tab, ctl, l);
            for (int e = 0; e < NEXP; ++e) {
                const float* bg = p.in[I_BGU] + ((size_t)l * NEXP + e) * 2048; const int cnt = tab[e], rb = tab[32 + e];
                for (int i = gw; i < cnt; i += NGW) {
                    const int pair = LIST[(size_t)e * LIST_CAP + i]; const float rs = RSTD[pair >> 2];
                    const float* hr = SCR + (size_t)(rb + i) * 2048; bf16* ar = ACT + (size_t)(rb + i) * D;
#pragma unroll
                    for (int j = 0; j < 16; ++j) { const int c = j * 64 + lane;
                        float gl = hr[c] * rs + bg[c], ln = hr[1024 + c] * rs + bg[1024 + c];
                        gl = fminf(gl, 7.0f); ln = fminf(fmaxf(ln, -7.0f), 7.0f);
                        const float a = gl * (1.0f / (1.0f + expf(-1.702f * gl))) * (ln + 1.0f);
                        ar[c] = (bf16)f2bf(a); }
                }
            }
            SEAM(PB + 12);
        }
        if (((MASK >> 13) & 1) && IN(PB + 13)) {
#if FAST_MB
            fg::build_exptab(lds, ctl, l, 4, G, bid);
            fg::CfgMB cfg; cfg.ws = ws; cfg.layer = l; cfg.bdn = p.in[I_BDN] + (size_t)l * NEXP * D; cfg.ldsb = lds;
            fg::gemm_phase(lds, cfg);
#else
            LAS int* tab = (LAS int*)(lds + 65536);
            load_exptab(tab, ctl, l);
            for (int e = 0; e < NEXP; ++e) {
                naive_gemm((LAS float*)lds, ACT + (size_t)tab[32 + e] * D, D, nullptr, tab[e], p.in[I_WDN] + ((size_t)l * NEXP + e) * D * D, D, gain1(nullptr),
                           D, D, SCR + (size_t)tab[32 + e] * D, D, bid, G);
            }
#endif
            SEAM(PB + 13);
        }
        if (!FAST_MB && ((MASK >> 14) & 1) && IN(PB + 14)) {
            LAS int* tab = (LAS int*)(lds + 65536);
            load_exptab(tab, ctl, l);
            for (int e = 0; e < NEXP; ++e) {
                const float* bd = p.in[I_BDN] + ((size_t)l * NEXP + e) * D; const int cnt = tab[e], rb = tab[32 + e];
                for (int i = gw; i < cnt; i += NGW) {
                    const int pair = LIST[(size_t)e * LIST_CAP + i]; const float g = GATE[pair];
                    const float* yr = SCR + (size_t)(rb + i) * D; bf16* yo = YB + (size_t)pair * D;
#pragma unroll
                    for (int j = 0; j < 16; ++j) { const int c = j * 64 + lane; yo[c] = (bf16)f2bf(g * (yr[c] + bd[c])); }
                }
            }
            SEAM(PB + 14);
        }
    }
#undef IN
#undef SEAM
}

template <unsigned MASK> static void launch_one(int grid, hipStream_t stream, const Params& p) {
    static bool attr_done = false;
    if (!attr_done) { (void)hipFuncSetAttribute((const void*)fwd<MASK>, hipFuncAttributeMaxDynamicSharedMemorySize, LDS_BYTES); attr_done = true; }
    hipLaunchKernelGGL(fwd<MASK>, dim3(grid), dim3(NTHREADS), LDS_BYTES, stream, p);
}
extern "C" void kernel_launch(void* const* d_in, const int* in_sizes, int n_in, void* d_out, int out_size, void* d_ws, size_t ws_size, hipStream_t stream) {
    static int grid = 0;
    if (grid == 0) {
        if (n_in != 27 || out_size != T * D || ws_size < WS_END) { fprintf(stderr, "kernel_launch: unexpected shapes: n_in %d out %d ws %zu\n", n_in, out_size, ws_size); grid = -1; return; }
        int dev = 0, cus = 0;
        if (hipGetDevice(&dev) != hipSuccess || hipDeviceGetAttribute(&cus, hipDeviceAttributeMultiprocessorCount, dev) != hipSuccess) { grid = -1; return; }
        grid = cus;
    }
    if (grid < 0) return;
    (void)hipMemsetAsync((char*)d_ws + WS_CTL, 0, CTL_ZERO_BYTES, stream);
    Params p{};
    for (int i = 0; i < 27; ++i) p.in[i] = (const float*)d_in[i];
    p.out = (float*)d_out; p.ws = (unsigned char*)d_ws;
    const int NPH = 1 + 16 * NLAYER + 1;
#if MK_ONE_LAUNCH
    p.ph_lo = 0; p.ph_hi = NPH;
    launch_one<0xFFFFu>(grid, stream, p);
#else
    if (FAST_G1 || FAST_G2 || FAST_MA || FAST_MB) { p.ph_lo = 0; p.ph_hi = 1; launch_one<1u << 15>(grid, stream, p); }
    for (int ph = 1; ph < NPH; ++ph) {
        const int s = (ph - 1) % 16; if (s == 15) continue;
        if ((FAST_G1 && s == 2) || (FAST_G2 && (s == 7 || s == 9)) || (FAST_MA && s == 12) || (FAST_MB && s == 14)) continue;
        p.ph_lo = ph; p.ph_hi = ph + 1;
        switch (s) {
            case 0: launch_one<1u << 0>(grid, stream, p); break;   case 1: launch_one<1u << 1>(grid, stream, p); break;
            case 2: launch_one<1u << 2>(grid, stream, p); break;   case 3: launch_one<1u << 3>(grid, stream, p); break;
            case 4: launch_one<1u << 4>(grid, stream, p); break;   case 5: launch_one<1u << 5>(grid, stream, p); break;
            case 6: launch_one<1u << 6>(grid, stream, p); break;   case 7: launch_one<1u << 7>(grid, stream, p); break;
            case 8: launch_one<1u << 8>(grid, stream, p); break;   case 9: launch_one<1u << 9>(grid, stream, p); break;
            case 10: launch_one<1u << 10>(grid, stream, p); break; case 11: launch_one<1u << 11>(grid, stream, p); break;
            case 12: launch_one<1u << 12>(grid, stream, p); break; case 13: launch_one<1u << 13>(grid, stream, p); break;
            case 14: launch_one<1u << 14>(grid, stream, p); break;
        }
    }
#endif
}
```

```cpp
#include <hip/hip_runtime.h>
#include <cstdio>
#include <cstdint>

#ifndef PROBE
#define PROBE -1
#endif
#ifndef MK_ONE_LAUNCH
#define MK_ONE_LAUNCH 1
#endif

#define GAS __attribute__((address_space(1)))
#define LAS __attribute__((address_space(3)))
typedef unsigned short bf16;
typedef float f32x4 __attribute__((ext_vector_type(4)));
typedef short bf16x8 __attribute__((ext_vector_type(8)));
typedef unsigned u32x4 __attribute__((ext_vector_type(4)));
typedef unsigned u32x2 __attribute__((ext_vector_type(2)));
typedef int i32x4 __attribute__((ext_vector_type(4)));

constexpr int T = 16384, SEQ = 2048, NBATCH = 8, D = 1024, NLAYER = 2, CHUNK = 64, NCH = 32;
constexpr int IN_W = 1952, NEXP = 32, TOPK = 4, DEXP = 1024;
constexpr float EPS = 1e-6f, LOG2E = 1.4426950408889634f;
constexpr float QSCALE_AC = 0.125f * LOG2E;
constexpr float QSCALE_B = 0.10206207261596575f * LOG2E;
constexpr int NROWS_MAX = (256 + 32) * 256;
constexpr int LIST_CAP = 16384;

constexpr size_t MiB = 1u << 20;
constexpr size_t WS_CTL = 0, CTL_ZERO_BYTES = 256 * 1024;
constexpr size_t WS_RSTD = 18 * MiB, WS_OSS = 19 * MiB, WS_SS1 = 20 * MiB, WS_TOPI = 21 * MiB, WS_GATE = 22 * MiB, WS_LIST = 24 * MiB;
constexpr size_t WS_XB = 32 * MiB, WS_QA = 64 * MiB, WS_KA = 80 * MiB, WS_VA = 84 * MiB, WS_QC = 88 * MiB, WS_KC = 96 * MiB, WS_VC = 104 * MiB;
constexpr size_t WS_BRAW = 112 * MiB, WS_QB = 128 * MiB, WS_KBN = 144 * MiB, WS_VB = 152 * MiB, WS_KPE = 160 * MiB, WS_O = 176 * MiB;
constexpr size_t WS_WR2 = 16 * MiB;
constexpr size_t WS_WB = 14 * MiB;
constexpr size_t WS_ROPE = 17 * MiB, WS_BSS = 23 * MiB;
constexpr size_t WS_WIN = 2 * MiB, WS_WOUT = 10 * MiB;
constexpr size_t WS_WGU = 256 * MiB, WS_WDN = 512 * MiB;
constexpr size_t WS_ACT = 640 * MiB, WS_Y = 800 * MiB;
constexpr size_t WS_X1 = 944 * MiB;
constexpr size_t WS_XB8 = 208 * MiB;
constexpr float W8SCALE = 64.0f, W8INV = 1.0f / 64.0f;
constexpr float Y8SCALE = 16.0f, Y8INV = 1.0f / 16.0f;
constexpr size_t WS_SCR = 1024 * MiB;
constexpr size_t WS_END = 1024 * MiB;
constexpr int CW_BAR = 4096;
constexpr int CW_MOE = 32768;
constexpr int CW_TMO = 8;
constexpr int CW_CNT = 16384;

constexpr int LDS_BYTES = 163840;
constexpr int NWAVES = 8, NTHREADS = 512;

__device__ __forceinline__ unsigned f2bf(float f) { unsigned u = __builtin_bit_cast(unsigned, f); return (u + 0x7fffu + ((u >> 16) & 1u)) >> 16; }
__device__ __forceinline__ unsigned pk2(float lo, float hi) { return f2bf(lo) | (f2bf(hi) << 16); }
__device__ __forceinline__ float bf2f(unsigned short b) { return __builtin_bit_cast(float, ((unsigned)b) << 16); }
__device__ __forceinline__ float bflo(unsigned w) { return __builtin_bit_cast(float, w << 16); }
__device__ __forceinline__ float bfhi(unsigned w) { return __builtin_bit_cast(float, w & 0xffff0000u); }
template <int O> __device__ __forceinline__ float xor_f(float v) { static_assert(O >= 1 && O < 32, "xor mask"); return __builtin_bit_cast(float, __builtin_amdgcn_ds_swizzle(__builtin_bit_cast(int, v), (O << 10) | 0x1f)); }
template <int O> __device__ __forceinline__ int xor_i(int v) { static_assert(O >= 1 && O < 32, "xor mask"); return __builtin_amdgcn_ds_swizzle(v, (O << 10) | 0x1f); }
__device__ __forceinline__ float pair_sum(float v) { const unsigned u = __builtin_bit_cast(unsigned, v); auto rr = __builtin_amdgcn_permlane32_swap(u, u, false, false); return __builtin_bit_cast(float, (unsigned)rr[0]) + __builtin_bit_cast(float, (unsigned)rr[1]); }
__device__ __forceinline__ float pair_max(float v) { const unsigned u = __builtin_bit_cast(unsigned, v); auto rr = __builtin_amdgcn_permlane32_swap(u, u, false, false); return fmaxf(__builtin_bit_cast(float, (unsigned)rr[0]), __builtin_bit_cast(float, (unsigned)rr[1])); }
__device__ __forceinline__ float wave_sum(float v) {
    v += xor_f<1>(v); v += xor_f<2>(v); v += xor_f<4>(v); v += xor_f<8>(v); v += xor_f<16>(v);
    return pair_sum(v);
}
__device__ __forceinline__ unsigned pk4_fp8(float a, float b, float c, float d) { unsigned w = 0u; w = __builtin_amdgcn_cvt_pk_fp8_f32(a, b, w, false); w = __builtin_amdgcn_cvt_pk_fp8_f32(c, d, w, true); return w; }
__device__ __forceinline__ int hidden_tid() { int t = threadIdx.x; asm volatile("" : "+v"(t)); return t; }
constexpr int PTAB_OFF = LDS_BYTES - 512;
__device__ __forceinline__ const float* ld_in(LAS unsigned char* lds, int i) { const u32x2 v = *(const LAS u32x2*)(lds + PTAB_OFF + i * 8);
    const unsigned long long a = ((unsigned long long)(unsigned)__builtin_amdgcn_readfirstlane((int)v.y) << 32) | (unsigned)__builtin_amdgcn_readfirstlane((int)v.x); return (const float*)a; }
__device__ __forceinline__ unsigned ld_agent(const unsigned* p) { return __hip_atomic_load(p, __ATOMIC_RELAXED, __HIP_MEMORY_SCOPE_AGENT); }

#define XB_TMO      128
#define XB_XCNT(j)  (256  + 64 * (j))
#define XB_XSUB(j)  (1280 + 64 * (j))
#define XB_XGEN(j)  (2304 + 64 * (j))
#define XB_TOP      3328
#define XB_TOPGEN   3392
#define XCD_BAR_WORDS 3456
#define XB_SPIN_CAP (1u << 18)
__device__ __forceinline__ unsigned xb_ld(unsigned* p)              { return __hip_atomic_load(p, __ATOMIC_RELAXED, __HIP_MEMORY_SCOPE_AGENT); }
__device__ __forceinline__ unsigned xb_add(unsigned* p, unsigned v) { return __hip_atomic_fetch_add(p, v, __ATOMIC_RELAXED, __HIP_MEMORY_SCOPE_AGENT); }
__device__ __forceinline__ unsigned xb_xcc_id() { return (unsigned)__builtin_amdgcn_s_getreg((3 << 11) | 20) & 0xFu; }
#define XB_SPIN(cond, bar) do { unsigned _sp = 0; while (cond) { __builtin_amdgcn_s_sleep(1); \
    if ((++_sp & 255u) == 0u) { if (xb_ld(&(bar)[XB_TMO])) break; if (_sp > XB_SPIN_CAP) { atomicAdd(&(bar)[XB_TMO], 1u); break; } } } } while (0)
struct XcdBarrier { unsigned* bar; unsigned x; volatile LAS unsigned* st; };
__device__ __forceinline__ XcdBarrier xcd_barrier_post(unsigned* bar, volatile LAS unsigned* st) {
    XcdBarrier b; b.bar = bar; b.x = xb_xcc_id(); b.st = st;
    if (threadIdx.x == 0) (void)xb_add(&bar[XB_XCNT(b.x)], 1u);
    return b;
}
__device__ __forceinline__ void xcd_barrier_complete(unsigned* bar, unsigned x, unsigned& nloc, unsigned& nx) {
    const unsigned G = gridDim.x * gridDim.y * gridDim.z;
    unsigned sum, cnt, mine, sp = 0u;
    for (;;) {
        sum = 0u; cnt = 0u; mine = 0u;
#pragma unroll
        for (unsigned j = 0; j < 16; ++j) { const unsigned c = xb_ld(&bar[XB_XCNT(j)]); sum += c; cnt += (c > 0u) ? 1u : 0u; mine = (j == x) ? c : mine; }
        if (sum == G) break;
        __builtin_amdgcn_s_sleep(1);
        if ((++sp & 255u) == 0u) { if (xb_ld(&bar[XB_TMO])) break; if (sp > XB_SPIN_CAP) { atomicAdd(&bar[XB_TMO], 1u); break; } }
    }
    nloc = mine > 0u ? mine : 1u; nx = cnt > 0u ? cnt : 1u;
}
__device__ __attribute__((noinline)) void xcd_barrier_impl(unsigned* bar, unsigned bx, volatile LAS unsigned* st) {
    XcdBarrier b; b.bar = bar; b.x = bx; b.st = st;
    asm volatile("s_waitcnt vmcnt(0)" ::: "memory");
    __syncthreads();
    if (threadIdx.x == 0) {
        unsigned* bar = b.bar;
        __builtin_amdgcn_s_waitcnt(0);
        unsigned nloc = b.st[0], nx = b.st[1];
        if (nloc == 0u) { xcd_barrier_complete(bar, b.x, nloc, nx); b.st[0] = nloc; b.st[1] = nx; }
        const unsigned old = xb_add(&bar[XB_XSUB(b.x)], 1u);
        const unsigned gen = old / nloc;
        if (old + 1u == (gen + 1u) * nloc) {
            __builtin_amdgcn_fence(__ATOMIC_RELEASE, "agent");
            asm volatile("s_waitcnt vmcnt(0)" ::: "memory");
            const unsigned og = xb_add(&bar[XB_TOP], 1u);
            const unsigned tg = og / nx;
            if (og + 1u == (tg + 1u) * nx) xb_add(&bar[XB_TOPGEN], 1u);
            else XB_SPIN(xb_ld(&bar[XB_TOPGEN]) == tg, bar);
            __builtin_amdgcn_fence(__ATOMIC_ACQUIRE, "agent");
            xb_add(&bar[XB_XGEN(b.x)], 1u);
            asm volatile("s_waitcnt vmcnt(0)" ::: "memory");
        } else {
            XB_SPIN(xb_ld(&bar[XB_XGEN(b.x)]) == gen, bar);
            __builtin_amdgcn_fence(__ATOMIC_ACQUIRE, "agent");
            asm volatile("s_waitcnt vmcnt(0)" ::: "memory");
        }
    }
    __syncthreads();
}

struct Params { const float* in[27]; float* out; unsigned char* ws; int ph_lo, ph_hi; };
enum { I_X = 0, I_ATTN_NORM, I_W_IN, I_AQN, I_AKN, I_ASINK, I_T5, I_BQAN, I_BWQB, I_BKVAN, I_BWKVB, I_BQN, I_BKN, I_CQN, I_CKN, I_CREL,
       I_AON, I_BON, I_CON, I_WOUT, I_FFN_NORM, I_WR, I_BR, I_WGU, I_BGU, I_WDN, I_BDN };

__device__ __forceinline__ int t5_bucket(int rel) {
    const int ret = rel > 0 ? 16 : 0; const int n = rel < 0 ? -rel : rel;
    if (n < 8) return ret + n;
    int large = 2 + (31 - __builtin_clz((unsigned)(n * n)));
    large = large > 15 ? 15 : large;
    return ret + large;
}

__device__ __forceinline__ int g1_colbase(int hh, int bj) {
    int base;
    if (hh < 8) base = hh * 64;
    else if (hh < 10) base = 512 + (hh - 8) * 64;
    else if (hh < 12) base = 640 + (hh - 10) * 64;
    else if (hh < 16) base = 1184 + (hh - 12) * 64;
    else if (hh < 20) base = 1440 + (hh - 16) * 64;
    else if (hh < 24) base = 1696 + (hh - 20) * 64;
    else if (hh < 28) base = 768 + (hh - 24) * 64;
    else if (hh < 30) base = 1024 + (hh - 28) * 64;
    else if (hh == 30) return bj == 0 ? 1152 : -1;
    else return -1;
    return base + 32 * bj;
}
struct CvtItem { const float* W; const float* g1; const float* g2; const float* g3; bf16* dst; int ldw, c0, k0, dpitch, kmax; bool fp8; };
__device__ __forceinline__ void cvt_decode(CvtItem& d, int it, LAS unsigned char* lds, unsigned char* ws) {
    constexpr int N_GU = 32 * 16 * 64, N_DN = 32 * 16 * 32, N_IN = 16 * 64, N_OUT = 16 * 32, N_B = 2 * 4 * 16, N_L = N_GU + N_DN + N_IN + N_OUT + N_B;
    const int l = it / N_L; int r = it - l * N_L;
    d.g1 = nullptr; d.g2 = nullptr; d.g3 = nullptr; d.dpitch = 1024; d.kmax = 1 << 30; d.fp8 = false;
    if (r < N_GU) { const int e = r >> 10, kb = (r >> 6) & 15, g = r & 63; const int pn = g >> 3, bj = (g >> 2) & 1, wc = g & 3;
        d.W = ld_in(lds, I_WGU) + ((size_t)l * NEXP + e) * D * 2048; d.ldw = 2048; d.c0 = bj * 1024 + 128 * pn + 32 * wc; d.k0 = kb * 64;
        d.dst = (bf16*)(ws + WS_WGU + (((size_t)l * NEXP + e) * 2048 + 32 * g) * 1024); d.fp8 = true; return; }
    r -= N_GU;
    if (r < N_DN) { const int e = r >> 9, kb = (r >> 5) & 15, g = r & 31;
        d.W = ld_in(lds, I_WDN) + ((size_t)l * NEXP + e) * D * D; d.ldw = D; d.c0 = 32 * g; d.k0 = kb * 64;
        d.dst = (bf16*)(ws + WS_WDN + (((size_t)l * NEXP + e) * 1024 + 32 * g) * 1024); d.fp8 = true; return; }
    r -= N_DN;
    if (r < N_IN) { const int kb = r >> 6, g = r & 63; const int pn = g >> 3, bj = (g >> 2) & 1, wc = g & 3;
        d.W = ld_in(lds, I_W_IN) + (size_t)l * D * IN_W; d.ldw = IN_W; d.c0 = g1_colbase(pn * 4 + wc, bj); d.g1 = ld_in(lds, I_ATTN_NORM) + l * D; d.k0 = kb * 64;
        d.dst = (bf16*)(ws + WS_WIN) + ((size_t)l * 2048 + 32 * g) * 1024; return; }
    r -= N_IN;
    if (r < N_OUT) { const int kb = r >> 5, g = r & 31;
        d.W = ld_in(lds, I_WOUT) + (size_t)l * D * D; d.ldw = D; d.c0 = 32 * g; d.g1 = ld_in(lds, I_AON) + l * 512; d.g2 = ld_in(lds, I_BON) + l * 256; d.g3 = ld_in(lds, I_CON) + l * 256; d.k0 = kb * 64;
        d.dst = (bf16*)(ws + WS_WOUT) + ((size_t)l * 1024 + 32 * g) * 1024; return; }
    r -= N_OUT;
    {
        const int which = r >> 6, kb = (r >> 4) & 3, g = r & 15; const int pn = g >> 3, bj = (g >> 2) & 1, wc = g & 3;
        if (which == 0) d.c0 = pn == 0 ? wc * 96 + 32 * bj : (bj == 0 ? wc * 96 + 64 : -1); else d.c0 = wc * 128 + 64 * pn + 32 * bj;
        d.dst = (bf16*)(ws + WS_WB) + (((size_t)l * 2 + which) * 512 + 32 * g) * 256; d.dpitch = 256; d.k0 = kb * 64;
        if (which == 0) { d.W = ld_in(lds, I_BWQB) + (size_t)l * 256 * 384; d.ldw = 384; d.g1 = ld_in(lds, I_BQAN) + l * 256; }
        else { d.W = ld_in(lds, I_BWKVB) + (size_t)l * 128 * 512; d.ldw = 512; d.g1 = ld_in(lds, I_BKVAN) + l * 128; d.kmax = 128; }
    }
}
__device__ __forceinline__ void cvt_load(const CvtItem& d, f32x4 (&v)[8], float (&gk)[8], int lane) {
#pragma unroll
    for (int j = 0; j < 8; ++j) {
        const int kk = (lane >> 3) + 8 * j, cq = (lane & 7) * 4, k = d.k0 + kk;
        v[j] = (f32x4){0.f, 0.f, 0.f, 0.f}; gk[j] = 1.f;
        if (d.c0 >= 0 && k < d.kmax) v[j] = __builtin_nontemporal_load((const f32x4*)(d.W + (size_t)k * d.ldw + d.c0 + cq));
        if (d.g1 && k < d.kmax) gk[j] = d.g2 ? (k < 512 ? d.g1[k] : (k < 768 ? d.g2[k - 512] : d.g3[k - 768])) : d.g1[k];
    }
}
__device__ __forceinline__ void cvt_store(const CvtItem& d, const f32x4 (&v)[8], const float (&gk)[8], LAS float* scr, int lane) {
#pragma unroll
    for (int j = 0; j < 8; ++j) { const int kk = (lane >> 3) + 8 * j, cq = (lane & 7) * 4; LAS float* p = scr + kk * 33 + cq;
        p[0] = v[j].x * gk[j]; p[1] = v[j].y * gk[j]; p[2] = v[j].z * gk[j]; p[3] = v[j].w * gk[j]; }
    asm volatile("s_waitcnt lgkmcnt(0)" ::: "memory");
    const int c = lane & 7;
#pragma unroll
    for (int j = 0; j < 4; ++j) {
        const int cc = (lane >> 3) + 8 * j; const LAS float* sp = scr + (8 * c) * 33 + cc;
        const int slot = 16 * ((cc >> 2) & 1) + 4 * (cc >> 3) + (cc & 3);
        if (d.fp8) { u32x2 o; o.x = pk4_fp8(sp[0] * W8SCALE, sp[33] * W8SCALE, sp[66] * W8SCALE, sp[99] * W8SCALE); o.y = pk4_fp8(sp[132] * W8SCALE, sp[165] * W8SCALE, sp[198] * W8SCALE, sp[231] * W8SCALE);
            *(u32x2*)((unsigned char*)d.dst + (size_t)slot * d.dpitch + d.k0 + 8 * c) = o; }
        else { u32x4 o; o.x = pk2(sp[0], sp[33]); o.y = pk2(sp[66], sp[99]); o.z = pk2(sp[132], sp[165]); o.w = pk2(sp[198], sp[231]);
            *(u32x4*)(d.dst + (size_t)slot * d.dpitch + d.k0 + 8 * c) = o; }
    }
    asm volatile("s_waitcnt lgkmcnt(0)" ::: "memory");
}
__device__ __forceinline__ void cvt_range(int first, int count, int small, LAS unsigned char* lds, unsigned char* ws, int gw, int NGW, int wave, int lane) {
    constexpr int NS = 16 * 64 + 16 * 32 + 2 * 4 * 16, NM = 32 * 16 * 64 + 32 * 16 * 32;
#define CVT_MAP(i) (small ? ((i) / NS) * (NM + NS) + NM + (i) % NS : first + (i))
    LAS float* scr = (LAS float*)(lds + wave * 16384);
    CvtItem da, db; f32x4 va[8], vb[8]; float ga[8], gb[8];
    int it = gw;
    if (it < count) { cvt_decode(da, CVT_MAP(it), lds, ws); cvt_load(da, va, ga, lane); }
    while (it < count) {
        const int it1 = it + NGW;
        if (it1 < count) { cvt_decode(db, CVT_MAP(it1), lds, ws); cvt_load(db, vb, gb, lane); }
        cvt_store(da, va, ga, scr, lane);
        if (it1 >= count) break;
        const int it2 = it1 + NGW;
        if (it2 < count) { cvt_decode(da, CVT_MAP(it2), lds, ws); cvt_load(da, va, ga, lane); }
        cvt_store(db, vb, gb, scr, lane);
        it = it2;
    }
}

#define GAS __attribute__((address_space(1)))
namespace bgc {
constexpr int NM_GU = 32 * 16 * 64, NM_DN = 32 * 16 * 32, NM = NM_GU + NM_DN;
constexpr int SCR_OFF = 143360, SCR_BYTES = 2304;
struct State { int next, end, fly, gw, ngw; f32x4 v[8]; };
__device__ __forceinline__ void decode(int f, int l, LAS unsigned char* lds, unsigned char* ws, const float*& src, unsigned char*& dst, int& ldw) {
    if (f < NM_GU) { const int e = f >> 10, kb = (f >> 6) & 15, g32 = f & 63, pn = g32 >> 3, bj = (g32 >> 2) & 1, wc = g32 & 3;
        src = ld_in(lds, I_WGU) + (((size_t)l * NEXP + e) * D + kb * 64) * 2048 + bj * 1024 + 128 * pn + 32 * wc; ldw = 2048;
        dst = ws + WS_WGU + (((size_t)l * NEXP + e) * 2048 + 32 * g32) * 1024 + kb * 64; }
    else { const int r = f - NM_GU; const int e = r >> 9, kb = (r >> 5) & 15, g32 = r & 31;
        src = ld_in(lds, I_WDN) + (((size_t)l * NEXP + e) * D + kb * 64) * D + 32 * g32; ldw = D;
        dst = ws + WS_WDN + (((size_t)l * NEXP + e) * 1024 + 32 * g32) * 1024 + kb * 64; }
}
__device__ __forceinline__ void init(State& s, int gw, int NGW) {
    s.gw = gw; s.ngw = NGW; s.next = 0; s.end = gw < NM ? (NM - gw + NGW - 1) / NGW : 0; s.fly = -1;
#pragma unroll
    for (int j = 0; j < 8; ++j) s.v[j] = (f32x4){0.f, 0.f, 0.f, 0.f};
}
__device__ __forceinline__ void step_finish(State& s, int l, LAS unsigned char* lds, unsigned char* ws) {
    if (s.fly < 0) return;
    const int tid = hidden_tid(), lane = tid & 63, wave = __builtin_amdgcn_readfirstlane(tid >> 6);
    LAS unsigned* scr = (LAS unsigned*)(lds + SCR_OFF + wave * SCR_BYTES);
    const float* src; unsigned char* dst; int ldw; decode(s.gw + s.fly * s.ngw, l, lds, ws, src, dst, ldw); (void)src; (void)ldw;
    LAS unsigned* wp = scr + (lane >> 3) * 9 + (lane & 7);
#pragma unroll
    for (int j = 0; j < 8; ++j) wp[j * 72] = pk4_fp8(s.v[j].x * W8SCALE, s.v[j].y * W8SCALE, s.v[j].z * W8SCALE, s.v[j].w * W8SCALE);
    asm volatile("" ::: "memory");
    const int ng = lane & 7, kg = lane >> 3; const LAS unsigned* sp = scr + (8 * kg) * 9 + ng;
    const unsigned d0 = sp[0], d1 = sp[9], d2 = sp[18], d3 = sp[27], d4 = sp[36], d5 = sp[45], d6 = sp[54], d7 = sp[63];
    asm volatile("" ::: "memory");
    const unsigned a01l = __builtin_amdgcn_perm(d1, d0, 0x05010400u), a01h = __builtin_amdgcn_perm(d1, d0, 0x07030602u), a23l = __builtin_amdgcn_perm(d3, d2, 0x05010400u), a23h = __builtin_amdgcn_perm(d3, d2, 0x07030602u);
    const unsigned b01l = __builtin_amdgcn_perm(d5, d4, 0x05010400u), b01h = __builtin_amdgcn_perm(d5, d4, 0x07030602u), b23l = __builtin_amdgcn_perm(d7, d6, 0x05010400u), b23h = __builtin_amdgcn_perm(d7, d6, 0x07030602u);
    GAS unsigned char* dp = (GAS unsigned char*)dst + (size_t)(16 * (ng & 1) + 4 * (ng >> 1)) * 1024 + 8 * kg;
    __builtin_nontemporal_store((u32x2){__builtin_amdgcn_perm(a23l, a01l, 0x05040100u), __builtin_amdgcn_perm(b23l, b01l, 0x05040100u)}, (GAS u32x2*)(dp));
    __builtin_nontemporal_store((u32x2){__builtin_amdgcn_perm(a23l, a01l, 0x07060302u), __builtin_amdgcn_perm(b23l, b01l, 0x07060302u)}, (GAS u32x2*)(dp + 1024));
    __builtin_nontemporal_store((u32x2){__builtin_amdgcn_perm(a23h, a01h, 0x05040100u), __builtin_amdgcn_perm(b23h, b01h, 0x05040100u)}, (GAS u32x2*)(dp + 2048));
    __builtin_nontemporal_store((u32x2){__builtin_amdgcn_perm(a23h, a01h, 0x07060302u), __builtin_amdgcn_perm(b23h, b01h, 0x07060302u)}, (GAS u32x2*)(dp + 3072));
    s.fly = -1;
}
__device__ __forceinline__ void step_issue(State& s, int l, LAS unsigned char* lds, unsigned char* ws) {
    if (s.next >= s.end) return;
    const int lane = hidden_tid() & 63;
    const float* src; unsigned char* dst; int ldw; decode(s.gw + s.next * s.ngw, l, lds, ws, src, dst, ldw); (void)dst;
    const GAS float* sp = (const GAS float*)src + (size_t)(lane >> 3) * ldw + 4 * (lane & 7);
#pragma unroll
    for (int j = 0; j < 8; ++j) s.v[j] = __builtin_nontemporal_load((const GAS f32x4*)(sp + (size_t)(8 * j) * ldw));
    s.fly = s.next; s.next += 1;
}
}
constexpr int N_MOE_L = 32 * 16 * 64 + 32 * 16 * 32;
constexpr int N_ITEMS_L = N_MOE_L + 16 * 64 + 16 * 32 + 2 * 4 * 16;
__device__ __forceinline__ void p0_convert(LAS unsigned char* lds, unsigned char* ws, int gw, int NGW, int wave, int lane) {
    cvt_range(0, NLAYER * (N_ITEMS_L - N_MOE_L), 1, lds, ws, gw, NGW, wave, lane);
    for (int i = gw * 64 + lane; i < NLAYER * 32 * 2 * 2 * 64 * 8; i += NGW * 64) {
        const int j = i & 7, ln = (i >> 3) & 63, term = (i >> 9) & 1, eh = (i >> 10) & 1, jj = (i >> 11) & 31, l = i >> 16; const int k = 32 * jj + 8 * (ln >> 4) + j, e = 16 * eh + (ln & 15);
        const float w = ld_in(lds, I_WR)[((size_t)l * D + k) * NEXP + e] * ld_in(lds, I_FFN_NORM)[l * D + k];
        const unsigned hi = f2bf(w); const float rest = w - __builtin_bit_cast(float, hi << 16);
        ((bf16*)(ws + WS_WR2))[i] = (bf16)(term ? f2bf(rest) : hi);
    }
    for (int i = gw * 64 + lane; i < SEQ * 16; i += NGW * 64) { const int pos = i >> 4, fi = i & 15; const float ang = (float)pos * powf(10000.0f, -((float)fi / 16.0f)); float sn, cs; sincosf(ang, &sn, &cs);
        ((float2*)(ws + WS_ROPE))[i] = make_float2(cs, sn); }
}

namespace fg {
constexpr int BK = 64, HALF = 128, HTB = HALF * BK * 2, STAGE_BYTES = 8 * HTB, NXCD = 8, WGM = 8;
constexpr int TAB_OFF = STAGE_BYTES, TAB_BYTES = 4096;
constexpr int EXPTAB_OFF = TAB_OFF + 2 * TAB_BYTES;
constexpr int ULIST_OFF = EXPTAB_OFF + 1024;
constexpr int GAIN_OFF = ULIST_OFF + 1024;
typedef f32x4 Acc[2][2][4][2];
__device__ __forceinline__ int lds_byte(int r, int c) { const int st = (r >> 4) * 2 + (c >> 5), rr = r & 15, cc = c & 31, ob = rr * 64 + cc * 2; return st * 1024 + (ob ^ (((ob >> 9) & 1) << 5)); }
__device__ __forceinline__ void stage_rc(int b, int& R, int& C) { const int st = b / 1024, sb = b % 1024, swz = sb ^ (((sb >> 9) & 1) << 5); R = (st >> 1) * 16 + swz / 64; C = (st & 1) * 32 + (swz % 64) / 2; }
__device__ __forceinline__ unsigned cvt_pk_bf16(float lo, float hi) { unsigned r; asm volatile("v_cvt_pk_bf16_f32 %0, %1, %2" : "=v"(r) : "v"(lo), "v"(hi)); return r; }
struct Unit { int a, b, c, d; };
typedef int v8i32 __attribute__((ext_vector_type(8)));
typedef int v4i32 __attribute__((ext_vector_type(4)));
__device__ __forceinline__ v8i32 cat8(bf16x8 lo, bf16x8 hi) { const v4i32 a = __builtin_bit_cast(v4i32, lo), b = __builtin_bit_cast(v4i32, hi); return (v8i32){a[0], a[1], a[2], a[3], b[0], b[1], b[2], b[3]}; }
typedef f32x4 AccT[2][2][4][2];
__device__ __forceinline__ void acc_zero(AccT& acc) {
#pragma unroll
    for (int a = 0; a < 2; ++a)
#pragma unroll
        for (int b = 0; b < 2; ++b)
#pragma unroll
            for (int m = 0; m < 4; ++m)
#pragma unroll
                for (int n = 0; n < 2; ++n) acc[a][b][m][n] = (f32x4){0.f, 0.f, 0.f, 0.f};
}
struct StaticOrder {
    int nM, nN, nwg, G, c;
    __device__ void init(int M, int N, int G_, int c_) { nM = M / 256; nN = N / 256; nwg = nM * nN; G = G_; c = c_; }
    __device__ bool next(int i, Unit& u) const {
        const long L = (long)i * G + c; if (L >= nwg) return false;
        int wgid = (int)L; { const int q = nwg / NXCD, r = nwg % NXCD, xcd = wgid % NXCD, off = wgid / NXCD; wgid = (xcd < r ? xcd * (q + 1) : r * (q + 1) + (xcd - r) * q) + off; }
        const int nig = WGM * nN, gid = wgid / nig, fm = gid * WGM, gsz = (nM - fm) < WGM ? (nM - fm) : WGM;
        u.a = fm + ((wgid % nig) % gsz); u.b = (wgid % nig) / gsz; u.c = 0; u.d = 0; return true;
    }
};

template <class C>
__device__ __forceinline__ void gemm_phase(LAS unsigned char* lds, const C& cfg) {
    const int tid = hidden_tid(), wid = __builtin_amdgcn_readfirstlane(tid >> 6), lane = tid & 63, wr = wid >> 2, wc = wid & 3, fr = lane & 15, fq = lane >> 4;
    unsigned voffB[1], voffA[C::GATHER ? 4 : 1];
    { int R, Cc; stage_rc(tid * 16, R, Cc); voffB[0] = (unsigned)(R * C::KDB + Cc * 2); if (!C::GATHER) voffA[0] = (unsigned)(R * C::LDAB + Cc * 2); }
#define FG_GATHER_OFFS(par) do { int tz = threadIdx.x; asm volatile("" : "+v"(tz)); _Pragma("unroll") for (int _i = 0; _i < 2; ++_i) { int R, Cc; stage_rc(tz * 16 + _i * 8192, R, Cc); \
        _Pragma("unroll") for (int _h = 0; _h < 2; ++_h) voffA[2 * _h + _i] = (unsigned)Cc * 2u + cfg.a_rowoff(par, _h * 128 + R, lds); } } while (0)
    const size_t kstep = (size_t)(BK * 2), hstep = (size_t)HALF * C::LDAB, hstepB = (size_t)HALF * C::KDB; constexpr int NT = C::KDB / (BK * 2);
    const unsigned ldsw = (unsigned)wid * 1024u;
    const int aoff = lds_byte(wr * 64 + fr, fq * 8), boff = lds_byte(wc * 32 + fr, fq * 8);
#define FG_SA(b, h) (((b) * 2 + (h)) * fg::HTB)
#define FG_SB(b, h) ((4 + (b) * 2 + (h)) * fg::HTB)
#define FG_STAGE(bufoff, gbase, voff, PSTEP) do { _Pragma("unroll") for (int _i = 0; _i < 2; ++_i) { const char* _gb = (const char*)(gbase) + (size_t)_i * (PSTEP); asm volatile("" : "+s"(_gb)); \
        __builtin_amdgcn_global_load_lds((const unsigned*)(_gb + (voff)[(PSTEP) ? 0 : _i]), (LAS unsigned*)(lds + (bufoff) + ldsw + _i * 8192), 16, 0, 0); } } while (0)
#define FG_STAGE_A(bufoff, gbase, h, vo) FG_STAGE(bufoff, (C::GATHER ? (gbase) : (gbase) + (h) * hstep), (C::GATHER ? (vo) + 2 * (h) : (vo)), (C::GATHER ? 0 : 64 * C::LDAB))
#define FG_STAGE_B(bufoff, gbase, h) FG_STAGE(bufoff, (gbase) + (h) * hstepB, voffB, 64 * C::KDB)
#define FG_LDA(dst, b, h) do { _Pragma("unroll") for (int m = 0; m < 4; ++m) _Pragma("unroll") for (int k = 0; k < 2; ++k) dst[m][k] = *(const LAS bf16x8*)(lds + FG_SA(b, h) + aoff + m * 2048 + k * 1024); } while (0)
#define FG_LDB(dst, b, h) do { _Pragma("unroll") for (int n = 0; n < 2; ++n) _Pragma("unroll") for (int k = 0; k < 2; ++k) dst[n][k] = *(const LAS bf16x8*)(lds + FG_SB(b, h) + boff + n * 2048 + k * 1024); } while (0)
#define FG_MMA(ai, bj, At, Bt) do { __builtin_amdgcn_s_setprio(1); _Pragma("unroll") for (int m = 0; m < 4; ++m) _Pragma("unroll") for (int n = 0; n < 2; ++n) { \
        if (C::FP8) { acc[ai][bj][m][n] = __builtin_amdgcn_mfma_scale_f32_16x16x128_f8f6f4(fg::cat8(Bt[n][0], Bt[n][1]), fg::cat8(At[m][0], At[m][1]), acc[ai][bj][m][n], 0, 0, 0, 0, 0, 0); } \
        else { _Pragma("unroll") for (int k = 0; k < 2; ++k) acc[ai][bj][m][n] = __builtin_amdgcn_mfma_f32_16x16x32_bf16(Bt[n][k], At[m][k], acc[ai][bj][m][n], 0, 0, 0); } } \
        __builtin_amdgcn_s_setprio(0); } while (0)
#define FG_WAIT_V(n) asm volatile("s_waitcnt vmcnt(" #n ")" ::: "memory")
#define FG_WAIT_L(n) asm volatile("s_waitcnt lgkmcnt(" #n ")" ::: "memory")
#define FG_BAR __builtin_amdgcn_s_barrier()
#define FG_SCHED __builtin_amdgcn_sched_barrier(0)
    Unit cur, nxt; int ui = 0; int pend = -1;
    if (!cfg.next(0, cur)) return;
    Acc acc;
    bf16x8 At[4][2], B0[2][2], B1[2][2];
    const char* cA = cfg.a_base(cur); const char* cB = cfg.b_base(cur);
    FG_STAGE_B(FG_SB(0, 0), cB, 0); FG_STAGE_B(FG_SB(0, 1), cB, 1);
    cfg.a_ready(cur, 0, lds);
    if (C::GATHER) FG_GATHER_OFFS(0);
    FG_STAGE_A(FG_SA(0, 0), cA, 0, voffA); FG_STAGE_A(FG_SA(0, 1), cA, 1, voffA);
    cfg.acc_init(acc, cur, 0, wr, wc, fr, fq, lds);
    if (wr == 1) FG_BAR;
    FG_WAIT_V(2); FG_BAR;
    FG_STAGE_B(FG_SB(1, 0), cB + kstep, 0); FG_STAGE_A(FG_SA(1, 0), cA + kstep, 0, voffA); FG_STAGE_B(FG_SB(1, 1), cB + kstep, 1);
    FG_WAIT_V(6); FG_BAR;
    for (;;) {
        const bool has_next = cfg.next(ui + 1, nxt);
        const char* nA = has_next ? cfg.a_base(nxt) : cA; const char* nB = has_next ? cfg.b_base(nxt) : cB;
#pragma nounroll
        for (int t = 0; t < NT; t += 2) {
            const bool last = (t == NT - 2);
            const char* a1 = cA + (size_t)(t + 1) * kstep;
            const char* a2 = last ? nA : cA + (size_t)(t + 2) * kstep; const char* b2 = last ? nB : cB + (size_t)(t + 2) * kstep;
            const char* a3 = a2 + kstep; const char* b3 = b2 + kstep;
            if (C::RESCALE) { if (t == 8 || t == 12) cfg.rescale(acc, t, ui & 1, wr, fr, lds); }
            FG_LDB(B0, 0, 0); FG_LDB(B1, 0, 1); FG_SCHED; FG_LDA(At, 0, 0); FG_STAGE_A(FG_SA(1, 1), a1, 1, voffA);
            FG_WAIT_V(8); FG_WAIT_L(0); FG_BAR; FG_MMA(0, 0, At, B0); FG_MMA(0, 1, At, B1); FG_BAR; FG_SCHED;
            if (last && has_next) { cfg.a_ready(nxt, (ui + 1) & 1, lds); if (C::GATHER) FG_GATHER_OFFS((ui + 1) & 1); }
            FG_LDA(At, 0, 1); FG_STAGE_B(FG_SB(0, 0), b2, 0); FG_STAGE_B(FG_SB(0, 1), b2, 1); FG_STAGE_A(FG_SA(0, 0), a2, 0, voffA);
            FG_WAIT_V(8); FG_WAIT_L(0); FG_BAR;
            if (C::PUBLISH) { if (t == 0 && pend >= 0) { cfg.publish(pend); pend = -1; } }
            FG_MMA(1, 0, At, B0); FG_MMA(1, 1, At, B1); FG_BAR; FG_SCHED;
            FG_LDB(B0, 1, 0); FG_LDB(B1, 1, 1); FG_SCHED; FG_LDA(At, 1, 0); FG_STAGE_A(FG_SA(0, 1), a2, 1, voffA);
            FG_WAIT_V(8); FG_WAIT_L(0); FG_BAR; FG_MMA(0, 0, At, B0); FG_MMA(0, 1, At, B1); FG_BAR; FG_SCHED;
            FG_LDA(At, 1, 1); FG_STAGE_B(FG_SB(1, 0), b3, 0); FG_STAGE_B(FG_SB(1, 1), b3, 1); FG_STAGE_A(FG_SA(1, 0), a3, 0, voffA);
            FG_WAIT_V(8); FG_WAIT_L(0); FG_BAR; FG_MMA(1, 0, At, B0); FG_MMA(1, 1, At, B1); FG_BAR; FG_SCHED;
        }
        if (wr == 0) FG_BAR;
        { const int tz = hidden_tid(), wz = __builtin_amdgcn_readfirstlane(tz >> 6), lz = tz & 63;
          cfg.epi(acc, cur, ui & 1, wz >> 2, wz & 3, lz & 15, lz >> 4, lds); }
        if (C::PUBLISH) pend = cfg.pub_id(cur);
        if (!has_next) break;
        cur = nxt; cA = nA; cB = nB; ++ui;
        { const int tz = hidden_tid(), wz = __builtin_amdgcn_readfirstlane(tz >> 6), lz = tz & 63; cfg.acc_init(acc, cur, ui & 1, wz >> 2, wz & 3, lz & 15, lz >> 4, lds); }
        if (wr == 1) FG_BAR;
    }
    FG_WAIT_V(0);
    if (C::PUBLISH) { if (pend >= 0) cfg.publish(pend); }
    FG_BAR;
}

struct HeadParams { bf16* dst; int pitch; const float* gain; float qs; bool norm, pe; float* ssq; };
__device__ __forceinline__ float pair_other(float v, int upper) { const unsigned u = __builtin_bit_cast(unsigned, v); auto rr = __builtin_amdgcn_permlane32_swap(u, u, false, false);
    return __builtin_bit_cast(float, upper ? (unsigned)rr[0] : (unsigned)rr[1]); }
template <class RS>
__device__ __forceinline__ void head_rows(const Acc& acc, const HeadParams& hp, int tile_row0, int wr, int fr, int fq, const RS& rowscale, const unsigned char* ws) {
    f32x4 gv[2][2];
#pragma unroll
    for (int bj = 0; bj < 2; ++bj)
#pragma unroll
        for (int n = 0; n < 2; ++n) gv[bj][n] = (hp.gain && !(hp.pe && bj == 1)) ? *(const f32x4*)(hp.gain + 32 * bj + 8 * fq + 4 * n) * hp.qs : (f32x4){1.f, 1.f, 1.f, 1.f};
#pragma unroll
    for (int ai = 0; ai < 2; ++ai)
#pragma unroll
        for (int m = 0; m < 4; ++m) {
            const int row = tile_row0 + ai * 128 + wr * 64 + m * 16 + fr;
            const float rs = rowscale(row);
            f32x4 v[2][2]; float ss0 = 0.f, ss1 = 0.f;
#pragma unroll
            for (int n = 0; n < 2; ++n) { v[0][n] = acc[ai][0][m][n] * rs; v[1][n] = acc[ai][1][m][n] * rs;
                ss0 += (v[0][n][0] * v[0][n][0] + v[0][n][1] * v[0][n][1]) + (v[0][n][2] * v[0][n][2] + v[0][n][3] * v[0][n][3]);
                ss1 += (v[1][n][0] * v[1][n][0] + v[1][n][1] * v[1][n][1]) + (v[1][n][2] * v[1][n][2] + v[1][n][3] * v[1][n][3]); }
            if (hp.ssq) { float t = ss0 + ss1; t += xor_f<16>(t); t = pair_sum(t); if (fq == 0) hp.ssq[(size_t)row * 8] = t; }
            float sc = 1.f;
            if (hp.norm) { float t = hp.pe ? ss0 : ss0 + ss1; t += xor_f<16>(t); t = pair_sum(t); sc = 1.0f / sqrtf(t * (hp.pe ? (1.f / 32) : (1.f / 64)) + EPS); }
            bf16* rowp = hp.dst + (size_t)row * hp.pitch + 8 * fq;
            if (hp.pe) {
                const f32x4 x0 = v[0][0] * gv[0][0] * sc, x1 = v[0][1] * gv[0][1] * sc;
                f32x4 y0, y1;
#pragma unroll
                for (int q = 0; q < 4; ++q) { y0[q] = pair_other(x0[q], fq >> 1); y1[q] = pair_other(x1[q], fq >> 1); }
                const f32x4* rp = (const f32x4*)((const float*)(ws + WS_ROPE) + ((size_t)(row & (SEQ - 1)) * 16 + 8 * (fq & 1)) * 2);
                const f32x4 t0 = rp[0], t1 = rp[1], t2 = rp[2], t3 = rp[3];
                const float sg = (fq >> 1) ? 1.f : -1.f;
                f32x4 r0, r1;
                r0[0] = x0[0] * t0[0] + sg * y0[0] * t0[1]; r0[1] = x0[1] * t0[2] + sg * y0[1] * t0[3]; r0[2] = x0[2] * t1[0] + sg * y0[2] * t1[1]; r0[3] = x0[3] * t1[2] + sg * y0[3] * t1[3];
                r1[0] = x1[0] * t2[0] + sg * y1[0] * t2[1]; r1[1] = x1[1] * t2[2] + sg * y1[1] * t2[3]; r1[2] = x1[2] * t3[0] + sg * y1[2] * t3[1]; r1[3] = x1[3] * t3[2] + sg * y1[3] * t3[3];
                u32x4 w; w.x = cvt_pk_bf16(r0[0], r0[1]); w.y = cvt_pk_bf16(r0[2], r0[3]); w.z = cvt_pk_bf16(r1[0], r1[1]); w.w = cvt_pk_bf16(r1[2], r1[3]);
                *(u32x4*)rowp = w;
            } else {
#pragma unroll
                for (int bj = 0; bj < 2; ++bj) { const f32x4 v0 = v[bj][0] * gv[bj][0] * sc, v1 = v[bj][1] * gv[bj][1] * sc;
                    u32x4 w; w.x = cvt_pk_bf16(v0[0], v0[1]); w.y = cvt_pk_bf16(v0[2], v0[3]); w.z = cvt_pk_bf16(v1[0], v1[1]); w.w = cvt_pk_bf16(v1[2], v1[3]);
                    *(u32x4*)(rowp + 32 * bj) = w; }
            }
        }
}
struct CfgG1 {
    static constexpr bool GATHER = false, RESCALE = false, FP8 = false; static constexpr int KD = 1024, KDB = 2048, LDAB = 2048;
    StaticOrder S; const bf16* A; const bf16* Bt; unsigned char* ws; const float* rstd;
    const float* aqn; const float* akn; const float* cqn; const float* ckn; const float* bkn;
    __device__ __forceinline__ bool next(int i, Unit& u) const { return S.next(i, u); }
    __device__ __forceinline__ const char* a_base(const Unit& u) const { return (const char*)A + (size_t)u.a * 256 * KD * 2; }
    __device__ __forceinline__ const char* b_base(const Unit& u) const { return (const char*)Bt + (size_t)u.b * 256 * KD * 2; }
    __device__ __forceinline__ void a_ready(const Unit& u, int par, LAS unsigned char* lds) const {
        const int tx = hidden_tid();
        if (tx < 256) *(LAS float*)(lds + TAB_OFF + par * TAB_BYTES + tx * 4) = rstd[u.a * 256 + tx];
    }
    __device__ __forceinline__ unsigned a_rowoff(int, int, LAS unsigned char*) const { return 0u; }
    __device__ __forceinline__ void acc_init(Acc& acc, const Unit&, int, int, int, int, int, LAS unsigned char*) const { acc_zero(acc); }
    static constexpr bool PUBLISH = false; __device__ __forceinline__ void publish(int) const {} __device__ __forceinline__ int pub_id(const Unit&) const { return -1; }
    __device__ __forceinline__ void rescale(Acc&, int, int, int, int, LAS unsigned char*) const {}
    __device__ __forceinline__ void epi(const Acc& acc, const Unit& u, int par, int wr, int wc, int fr, int fq, LAS unsigned char* lds) const {
        const int hh = u.b * 4 + wc;
        const int npass = hh == 30 ? 2 : 1;
        for (int pass = 0; pass < npass; ++pass) {
            HeadParams hp; hp.gain = nullptr; hp.qs = 1.f; hp.norm = false; hp.pe = false; hp.ssq = nullptr;
            if (pass == 1) { hp.dst = (bf16*)(ws + WS_KPE); hp.pitch = 32; hp.gain = bkn + 64; hp.norm = true; hp.pe = true; }
            else if (hh < 8) { hp.dst = (bf16*)(ws + WS_QA) + hh * 64; hp.pitch = 512; hp.gain = aqn; hp.qs = QSCALE_AC; hp.norm = true; }
            else if (hh < 10) { hp.dst = (bf16*)(ws + WS_KA) + (hh - 8) * 64; hp.pitch = 128; hp.gain = akn; hp.norm = true; }
            else if (hh < 12) { hp.dst = (bf16*)(ws + WS_VA) + (hh - 10) * 64; hp.pitch = 128; }
            else if (hh < 16) { hp.dst = (bf16*)(ws + WS_QC) + (hh - 12) * 64; hp.pitch = 256; hp.gain = cqn; hp.qs = QSCALE_AC; hp.norm = true; }
            else if (hh < 20) { hp.dst = (bf16*)(ws + WS_KC) + (hh - 16) * 64; hp.pitch = 256; hp.gain = ckn; hp.norm = true; }
            else if (hh < 24) { hp.dst = (bf16*)(ws + WS_VC) + (hh - 20) * 64; hp.pitch = 256; }
            else { hp.dst = (bf16*)(ws + WS_BRAW) + (hh - 24) * 64; hp.pitch = 512; if (hh < 30) hp.ssq = (float*)(ws + WS_BSS) + (hh - 24); }
            const LAS float* rsp = (const LAS float*)(lds + TAB_OFF + par * TAB_BYTES) - u.a * 256;
            head_rows(acc, hp, u.a * 256, wr, fr, fq, [rsp](int row) { return rsp[row]; }, ws);
        }
    }
};
struct CfgGB {
    static constexpr bool GATHER = false, RESCALE = false, FP8 = false; static constexpr int KD = 256, KDB = 512, LDAB = 1024;
    int G, c, layer; unsigned char* ws; const float* bqn; const float* bkn;
    __device__ __forceinline__ bool next(int i, Unit& u) const { const int L = i * G + c; if (L >= 256) return false; u.a = L >> 2; u.b = (L >> 1) & 1; u.c = L & 1; u.d = 0; return true; }
    __device__ __forceinline__ const char* a_base(const Unit& u) const { return (const char*)(ws + WS_BRAW) + ((size_t)u.a * 256 * 512 + u.b * 256) * 2; }
    __device__ __forceinline__ const char* b_base(const Unit& u) const { return (const char*)(ws + WS_WB) + ((((size_t)layer * 2 + u.b) * 512 + u.c * 256) * 256) * 2; }
    __device__ __forceinline__ void a_ready(const Unit&, int, LAS unsigned char*) const {}
    __device__ __forceinline__ unsigned a_rowoff(int, int, LAS unsigned char*) const { return 0u; }
    __device__ __forceinline__ void acc_init(Acc& acc, const Unit&, int, int, int, int, int, LAS unsigned char*) const { acc_zero(acc); }
    static constexpr bool PUBLISH = false; __device__ __forceinline__ void publish(int) const {} __device__ __forceinline__ int pub_id(const Unit&) const { return -1; }
    __device__ __forceinline__ void rescale(Acc&, int, int, int, int, LAS unsigned char*) const {}
    __device__ __forceinline__ void epi(const Acc& acc, const Unit& u, int par, int wr, int wc, int fr, int fq, LAS unsigned char* lds) const {
        HeadParams hp; hp.gain = nullptr; hp.qs = 1.f; hp.norm = false; hp.pe = false; hp.ssq = nullptr;
        if (u.b == 0 && u.c == 0) { hp.dst = (bf16*)(ws + WS_QB) + wc * 96; hp.pitch = 384; hp.gain = bqn; hp.qs = QSCALE_B; hp.norm = true; }
        else if (u.b == 0) { hp.dst = (bf16*)(ws + WS_QB) + wc * 96 + 64; hp.pitch = 384; hp.gain = bqn + 64; hp.qs = QSCALE_B; hp.norm = true; hp.pe = true; }
        else if (u.c == 0) { hp.dst = (bf16*)(ws + WS_KBN) + wc * 64; hp.pitch = 256; hp.gain = bkn; hp.norm = true; }
        else { hp.dst = (bf16*)(ws + WS_VB) + wc * 64; hp.pitch = 256; }
        const float* bss = (const float*)(ws + WS_BSS); const int which = u.b;
        head_rows(acc, hp, u.a * 256, wr, fr, fq, [bss, which](int row) { const f32x4 a = *(const f32x4*)(bss + (size_t)row * 8), b = *(const f32x4*)(bss + (size_t)row * 8 + 4);
            return which == 0 ? 1.0f / sqrtf(((a[0] + a[1]) + (a[2] + a[3])) * (1.f / 256) + EPS) : 1.0f / sqrtf((b[0] + b[1]) * (1.f / 128) + EPS); }, ws);
    }
};

struct CfgG2 {
    static constexpr bool GATHER = false, RESCALE = true, FP8 = false; static constexpr int KD = 1024, KDB = 2048, LDAB = 2048;
    StaticOrder S; const bf16* A; const bf16* Bt; unsigned char* ws; const bf16* xin; bf16* xout; const float* fgain;
    __device__ __forceinline__ bool next(int i, Unit& u) const { return S.next(i, u); }
    __device__ __forceinline__ const char* a_base(const Unit& u) const { return (const char*)A + (size_t)u.a * 256 * KD * 2; }
    __device__ __forceinline__ const char* b_base(const Unit& u) const { return (const char*)Bt + (size_t)u.b * 256 * KD * 2; }
    __device__ __forceinline__ unsigned a_rowoff(int, int, LAS unsigned char*) const { return 0u; }
    __device__ __forceinline__ void a_ready(const Unit& u, int par, LAS unsigned char* lds) const {
        const int tx = hidden_tid();
        if (tx < 256) {
            const float* o = (const float*)(ws + WS_OSS) + (size_t)(u.a * 256 + tx) * 16;
            const f32x4 s0 = *(const f32x4*)o, s1 = *(const f32x4*)(o + 4), s2 = *(const f32x4*)(o + 8), s3 = *(const f32x4*)(o + 12);
            const float sa = (s0[0] + s0[1] + s0[2] + s0[3]) + (s1[0] + s1[1] + s1[2] + s1[3]), sb = s2[0] + s2[1] + s2[2] + s2[3], sc = s3[0] + s3[1] + s3[2] + s3[3];
            const float ra = 1.0f / sqrtf(sa * (1.f / 512) + EPS), rb = 1.0f / sqrtf(sb * (1.f / 256) + EPS), rc = 1.0f / sqrtf(sc * (1.f / 256) + EPS);
            *(LAS f32x4*)(lds + TAB_OFF + par * TAB_BYTES + tx * 16) = (f32x4){ra / rb, rb / rc, rc, 0.f};
            *(LAS float*)(lds + GAIN_OFF + par * 1024 + tx * 4) = fgain[u.b * 256 + tx];
        }
        asm volatile("s_waitcnt lgkmcnt(0)" ::: "memory"); __builtin_amdgcn_s_barrier(); asm volatile("" ::: "memory");
    }
    __device__ __forceinline__ void acc_init(Acc& acc, const Unit& u, int par, int wr, int wc, int fr, int fq, LAS unsigned char* lds) const {
#pragma unroll
        for (int ai = 0; ai < 2; ++ai)
#pragma unroll
            for (int m = 0; m < 4; ++m) {
                const int rl = ai * 128 + wr * 64 + m * 16 + fr; const int row = u.a * 256 + rl;
                const f32x4 f = *(const LAS f32x4*)(lds + TAB_OFF + par * TAB_BYTES + rl * 16);
                const float inv = 1.0f / (f[0] * f[1] * f[2]);
#pragma unroll
                for (int bj = 0; bj < 2; ++bj) { const size_t off = (size_t)row * D + u.b * 256 + bj * 128 + wc * 32 + 8 * fq;
                    const u32x4 xw = *(const u32x4*)(xin + off);
                    acc[ai][bj][m][0] = (f32x4){bflo(xw.x), bfhi(xw.x), bflo(xw.y), bfhi(xw.y)} * inv; acc[ai][bj][m][1] = (f32x4){bflo(xw.z), bfhi(xw.z), bflo(xw.w), bfhi(xw.w)} * inv; }
            }
    }
    static constexpr bool PUBLISH = false; __device__ __forceinline__ void publish(int) const {} __device__ __forceinline__ int pub_id(const Unit&) const { return -1; }
    __device__ __forceinline__ void rescale(Acc& acc, int t, int par, int wr, int fr, LAS unsigned char* lds) const {
        const int which = (t == 8) ? 0 : 1;
#pragma unroll
        for (int ai = 0; ai < 2; ++ai)
#pragma unroll
            for (int m = 0; m < 4; ++m) { const int row = ai * 128 + wr * 64 + m * 16 + fr;
                const float f = *(const LAS float*)(lds + TAB_OFF + par * TAB_BYTES + row * 16 + which * 4);
#pragma unroll
                for (int bj = 0; bj < 2; ++bj)
#pragma unroll
                    for (int n = 0; n < 2; ++n) acc[ai][bj][m][n] = acc[ai][bj][m][n] * f; }
    }
    __device__ __forceinline__ void epi(const Acc& acc, const Unit& u, int par, int wr, int wc, int fr, int fq, LAS unsigned char* lds) const {
#pragma unroll
        for (int ai = 0; ai < 2; ++ai)
#pragma unroll
            for (int m = 0; m < 4; ++m) {
                const int rl = ai * 128 + wr * 64 + m * 16 + fr; const int row = u.a * 256 + rl;
                const float rc = *(const LAS float*)(lds + TAB_OFF + par * TAB_BYTES + rl * 16 + 8);
                float ss = 0.f;
#pragma unroll
                for (int bj = 0; bj < 2; ++bj) {
                    const size_t off = (size_t)row * D + u.b * 256 + bj * 128 + wc * 32 + 8 * fq;
                    const f32x4 x0 = acc[ai][bj][m][0] * rc, x1 = acc[ai][bj][m][1] * rc;
                    ss += (x0[0] * x0[0] + x0[1] * x0[1]) + (x0[2] * x0[2] + x0[3] * x0[3]) + (x1[0] * x1[0] + x1[1] * x1[1]) + (x1[2] * x1[2] + x1[3] * x1[3]);
                    { u32x4 xw; xw.x = cvt_pk_bf16(x0[0], x0[1]); xw.y = cvt_pk_bf16(x0[2], x0[3]); xw.z = cvt_pk_bf16(x1[0], x1[1]); xw.w = cvt_pk_bf16(x1[2], x1[3]); *(u32x4*)(xout + off) = xw; }
                    const f32x4 g0 = *(const LAS f32x4*)(lds + GAIN_OFF + par * 1024 + (bj * 128 + wc * 32 + 8 * fq) * 4), g1 = *(const LAS f32x4*)(lds + GAIN_OFF + par * 1024 + (bj * 128 + wc * 32 + 8 * fq + 4) * 4);
                    u32x2 w; w.x = pk4_fp8(x0[0] * g0[0], x0[1] * g0[1], x0[2] * g0[2], x0[3] * g0[3]); w.y = pk4_fp8(x1[0] * g1[0], x1[1] * g1[1], x1[2] * g1[2], x1[3] * g1[3]);
                    *(u32x2*)(ws + WS_XB8 + off) = w;
                }
                ss += xor_f<16>(ss); ss = pair_sum(ss);
                if (fq == 0) ((float*)(ws + WS_SS1))[(size_t)row * 16 + u.b * 4 + wc] = ss;
            }
    }
};

__device__ __forceinline__ void build_exptab(LAS unsigned char* lds, const unsigned* ctl, int layer, int ntn, int G, int c) {
    LAS int* tab = (LAS int*)(lds + EXPTAB_OFF); const int tx = hidden_tid();
    if (tx < 32) tab[tx] = (int)ld_agent(ctl + CW_CNT + (layer * 32 + tx) * 64);
    __syncthreads();
    if (tx == 0) { int tb = 0; for (int e = 0; e < 32; ++e) { tab[32 + e] = tb * 256; tab[65 + e] = tb; tb += (tab[e] + 255) / 256; } tab[64] = tb * 256; tab[97] = tb; }
    __syncthreads();
    if (tx < 24) {
        int tg, pn;
        if ((G & 7) == 0 && ((G >> 3) % ntn) == 0) { const int x = c & 7, j = c >> 3, tpr = (G >> 3) / ntn, tpx = (tab[97] + 7) >> 3, lt = tx * tpr + j / ntn;
            tg = lt < tpx ? x * tpx + lt : (1 << 20); pn = j % ntn; }
        else { const int L = tx * G + c; tg = L / ntn; pn = L % ntn; }
        i32x4 ent = (i32x4){-1, 0, 0, 0};
        if (tg < tab[97]) { int e = 0; for (int k = 0; k < 32; ++k) e += (tg >= tab[65 + k + 1]) ? 1 : 0; ent = (i32x4){e, tg - tab[65 + e], pn, tab[32 + e] + (tg - tab[65 + e]) * 256}; }
        *(LAS i32x4*)(lds + ULIST_OFF + tx * 16) = ent;
    }
    __syncthreads();
}
struct CfgMA {
    static constexpr bool GATHER = true, RESCALE = false, FP8 = true, PUBLISH = true; static constexpr int KDB = 1024, LDAB = 1024;
    unsigned char* ws; int layer; const float* bgu; LAS unsigned char* ldsb; unsigned* ctl;
    __device__ __forceinline__ bool next(int i, Unit& u) const { if (i >= 24) return false; const i32x4 e = *(const LAS i32x4*)(ldsb + ULIST_OFF + i * 16);
        u.a = __builtin_amdgcn_readfirstlane(e.x); u.b = __builtin_amdgcn_readfirstlane(e.y); u.c = __builtin_amdgcn_readfirstlane(e.z); u.d = __builtin_amdgcn_readfirstlane(e.w); return u.a >= 0; }
    __device__ __forceinline__ const char* a_base(const Unit&) const { return (const char*)(ws + WS_XB8); }
    __device__ __forceinline__ const char* b_base(const Unit& u) const { return (const char*)(ws + WS_WGU) + (((size_t)layer * NEXP + u.a) * 2048 + (size_t)u.c * 256) * KDB; }
    __device__ __forceinline__ void a_ready(const Unit& u, int par, LAS unsigned char* lds) const {
        const int tx = hidden_tid();
        if (tx < 256) {
            const LAS int* tab = (const LAS int*)(lds + EXPTAB_OFF); const int cnt = tab[u.a]; int i = u.b * 256 + tx; if (i >= cnt) i = 0;
            const int pair = ((const int*)(ws + WS_LIST))[(size_t)u.a * LIST_CAP + i]; const int tok = pair >> 2;
            *(LAS int*)(lds + TAB_OFF + par * TAB_BYTES + tx * 4) = tok;
            *(LAS float*)(lds + TAB_OFF + par * TAB_BYTES + 1024 + tx * 4) = ((const float*)(ws + WS_RSTD))[tok];
        }
        asm volatile("s_waitcnt lgkmcnt(0)" ::: "memory"); __builtin_amdgcn_s_barrier(); asm volatile("" ::: "memory");
    }
    __device__ __forceinline__ unsigned a_rowoff(int par, int row, LAS unsigned char* lds) const { return (unsigned)(*(const LAS int*)(lds + TAB_OFF + par * TAB_BYTES + row * 4)) * (unsigned)LDAB; }
    __device__ __forceinline__ void acc_init(Acc& acc, const Unit&, int, int, int, int, int, LAS unsigned char*) const { acc_zero(acc); }
    __device__ __forceinline__ void rescale(Acc&, int, int, int, int, LAS unsigned char*) const {}
    __device__ __forceinline__ void epi(const Acc& acc, const Unit& u, int par, int wr, int wc, int fr, int fq, LAS unsigned char* lds) const {
        const int j0 = 128 * u.c + 32 * wc + 8 * fq; const float* bg = bgu + (size_t)u.a * 2048;
        const f32x4 bgl0 = *(const f32x4*)(bg + j0), bgl1 = *(const f32x4*)(bg + j0 + 4), bli0 = *(const f32x4*)(bg + 1024 + j0), bli1 = *(const f32x4*)(bg + 1024 + j0 + 4);
        const int rbase = u.d;
        bf16* act = (bf16*)(ws + WS_ACT);
#pragma unroll
        for (int ai = 0; ai < 2; ++ai)
#pragma unroll
            for (int m = 0; m < 4; ++m) {
                const int rl = ai * 128 + wr * 64 + m * 16 + fr;
                const float rs = *(const LAS float*)(lds + TAB_OFF + par * TAB_BYTES + 1024 + rl * 4) * W8INV;
                f32x4 gl0 = acc[ai][0][m][0] * rs + bgl0, gl1 = acc[ai][0][m][1] * rs + bgl1, li0 = acc[ai][1][m][0] * rs + bli0, li1 = acc[ai][1][m][1] * rs + bli1;
                float a[8];
#pragma unroll
                for (int q = 0; q < 4; ++q) {
                    float g = fminf(gl0[q], 7.0f), lv = fminf(fmaxf(li0[q], -7.0f), 7.0f);
                    a[q] = g * __builtin_amdgcn_rcpf(1.0f + __builtin_amdgcn_exp2f(-1.702f * LOG2E * g)) * (lv + 1.0f);
                    g = fminf(gl1[q], 7.0f); lv = fminf(fmaxf(li1[q], -7.0f), 7.0f);
                    a[4 + q] = g * __builtin_amdgcn_rcpf(1.0f + __builtin_amdgcn_exp2f(-1.702f * LOG2E * g)) * (lv + 1.0f);
                }
                const unsigned long long w = (unsigned long long)pk4_fp8(a[0], a[1], a[2], a[3]) | ((unsigned long long)pk4_fp8(a[4], a[5], a[6], a[7]) << 32);
                __hip_atomic_store((unsigned long long*)((unsigned char*)act + (size_t)(rbase + rl) * DEXP + j0), w, __ATOMIC_RELAXED, __HIP_MEMORY_SCOPE_AGENT);
            }
    }
    __device__ __forceinline__ void publish(int tile) const { if ((hidden_tid() & 63) == 0) __hip_atomic_fetch_add(ctl + CW_MOE + (layer * 320 + tile) * 16, 1u, __ATOMIC_RELAXED, __HIP_MEMORY_SCOPE_AGENT); }
    __device__ __forceinline__ int pub_id(const Unit& u) const { return u.d >> 8; }
};
struct CfgMB {
    static constexpr bool GATHER = false, RESCALE = false, FP8 = true; static constexpr int KDB = 1024, LDAB = 1024;
    unsigned char* ws; int layer; const float* bdn; LAS unsigned char* ldsb; unsigned* ctl;
    __device__ __forceinline__ bool next(int i, Unit& u) const { if (i >= 24) return false; const i32x4 e = *(const LAS i32x4*)(ldsb + ULIST_OFF + i * 16);
        u.a = __builtin_amdgcn_readfirstlane(e.x); u.b = __builtin_amdgcn_readfirstlane(e.y); u.c = __builtin_amdgcn_readfirstlane(e.z); u.d = __builtin_amdgcn_readfirstlane(e.w); return u.a >= 0; }
    __device__ __forceinline__ const char* a_base(const Unit& u) const { return (const char*)(ws + WS_ACT) + (size_t)u.d * LDAB; }
    __device__ __forceinline__ const char* b_base(const Unit& u) const { return (const char*)(ws + WS_WDN) + (((size_t)layer * NEXP + u.a) * 1024 + (size_t)u.c * 256) * KDB; }
    __device__ __forceinline__ void a_ready(const Unit& u, int par, LAS unsigned char* lds) const {
        const int tx = hidden_tid();
        if (tx < 64) {
            unsigned* cw = ctl + CW_MOE + (layer * 320 + (u.d >> 8)) * 16; unsigned spins = 0;
            while ((unsigned)__builtin_amdgcn_readfirstlane((int)__hip_atomic_load(cw, __ATOMIC_RELAXED, __HIP_MEMORY_SCOPE_AGENT)) < 64u) {
                __builtin_amdgcn_s_sleep(2);
                if ((++spins & 1023u) == 0u) { if (__hip_atomic_load(ctl + CW_TMO, __ATOMIC_RELAXED, __HIP_MEMORY_SCOPE_AGENT) != 0u) break;
                    if (spins > (1u << 22)) { __hip_atomic_store(ctl + CW_TMO, 1u, __ATOMIC_RELAXED, __HIP_MEMORY_SCOPE_AGENT); break; } }
            }
            __builtin_amdgcn_fence(__ATOMIC_ACQUIRE, "agent");
            asm volatile("s_waitcnt vmcnt(0)" ::: "memory");
        }
        if (tx < 256) {
            const LAS int* tab = (const LAS int*)(lds + EXPTAB_OFF); const int cnt = tab[u.a]; const int i = u.b * 256 + tx;
            int pair = -1; float g = 0.f;
            if (i < cnt) { pair = ((const int*)(ws + WS_LIST))[(size_t)u.a * LIST_CAP + i]; g = ((const float*)(ws + WS_GATE))[pair]; }
            *(LAS int*)(lds + TAB_OFF + par * TAB_BYTES + tx * 4) = pair;
            *(LAS float*)(lds + TAB_OFF + par * TAB_BYTES + 1024 + tx * 4) = g;
        }
        asm volatile("s_waitcnt lgkmcnt(0)" ::: "memory"); __builtin_amdgcn_s_barrier(); asm volatile("" ::: "memory");
    }
    __device__ __forceinline__ unsigned a_rowoff(int, int, LAS unsigned char*) const { return 0u; }
    __device__ __forceinline__ void acc_init(Acc& acc, const Unit&, int, int, int, int, int, LAS unsigned char*) const { acc_zero(acc); }
    static constexpr bool PUBLISH = false; __device__ __forceinline__ void publish(int) const {} __device__ __forceinline__ int pub_id(const Unit&) const { return -1; }
    __device__ __forceinline__ void rescale(Acc&, int, int, int, int, LAS unsigned char*) const {}
    __device__ __forceinline__ void epi(const Acc& acc, const Unit& u, int par, int wr, int wc, int fr, int fq, LAS unsigned char* lds) const {
        const int c0 = 256 * u.c + 32 * wc + 8 * fq; const float* bd = bdn + (size_t)u.a * D;
        f32x4 bv[2][2];
#pragma unroll
        for (int bj = 0; bj < 2; ++bj) { bv[bj][0] = *(const f32x4*)(bd + c0 + 128 * bj); bv[bj][1] = *(const f32x4*)(bd + c0 + 128 * bj + 4); }
        bf16* yb = (bf16*)(ws + WS_Y);
#pragma unroll
        for (int ai = 0; ai < 2; ++ai)
#pragma unroll
            for (int m = 0; m < 4; ++m) {
                const int rl = ai * 128 + wr * 64 + m * 16 + fr;
                int pair = *(const LAS int*)(lds + TAB_OFF + par * TAB_BYTES + rl * 4);
                const float g = *(const LAS float*)(lds + TAB_OFF + par * TAB_BYTES + 1024 + rl * 4);
                pair = pair < 0 ? T * TOPK + rl : pair;
#pragma unroll
                for (int bj = 0; bj < 2; ++bj) { const f32x4 v0 = (acc[ai][bj][m][0] * W8INV + bv[bj][0]) * (g * Y8SCALE), v1 = (acc[ai][bj][m][1] * W8INV + bv[bj][1]) * (g * Y8SCALE);
                    u32x2 w; w.x = pk4_fp8(v0[0], v0[1], v0[2], v0[3]); w.y = pk4_fp8(v1[0], v1[1], v1[2], v1[3]);
                    *(u32x2*)((unsigned char*)yb + (size_t)pair * D + c0 + 128 * bj) = w; }
            }
    }
};
}


namespace att {
typedef float f32x16 __attribute__((ext_vector_type(16)));
typedef short s16x4 __attribute__((ext_vector_type(4)));
typedef float f32x2_t __attribute__((ext_vector_type(2))); typedef __bf16 bf16x2_t __attribute__((ext_vector_type(2)));
__device__ __forceinline__ unsigned cvtpk(float lo, float hi) { f32x2_t v = {lo, hi}; bf16x2_t b = __builtin_convertvector(v, bf16x2_t); return __builtin_bit_cast(unsigned, b); }
__device__ __forceinline__ s16x4 vtr(unsigned addr) { return __builtin_bit_cast(s16x4, __builtin_amdgcn_ds_read_tr16_b64_v4i16((LAS s16x4*)(size_t)addr)); }
constexpr int TAB_LDS = 131072;
constexpr int QW_A = 512 * 4, QW_C = 256 * 4;
constexpr int CW_QUEUE = 24576;
__device__ __forceinline__ int swz8(int key) { const int y = (key >> 1) & 7; return ((y & 1) << 2) | (y >> 1); }

template <int KIND>
__device__ __forceinline__ void unit(LAS unsigned char* lds, unsigned char* ws, int b, int n, int kvh, const float* sinks, bgc::State& bg, int lyr) {
    constexpr int NS = KIND == 1 ? 6 : 4;
    constexpr int BUFB = KIND == 1 ? 69632 : 65536;
    constexpr int NPREV = KIND == 0 ? 2 : (KIND == 1 ? 32 : 8);
    constexpr int TABN = KIND == 0 ? 256 : 640, OFF = KIND == 0 ? 191 : 575;
    const int tid = hidden_tid(), lane = tid & 63, wave = __builtin_amdgcn_readfirstlane(tid >> 6), hw = wave >> 1, qh = wave & 1, r32 = lane & 31, hh = lane >> 5;
    const int kslot = KIND == 0 ? 0 : hw;
    const int tok0 = b * SEQ;
    const int tq = tok0 + n * 64 + qh * 32 + r32;
    bf16x8 qf[NS];
    {
        const bf16* qrow = KIND == 0 ? (const bf16*)(ws + WS_QA) + (size_t)tq * 512 + (kvh * 4 + hw) * 64
                         : (KIND == 1 ? (const bf16*)(ws + WS_QB) + (size_t)tq * 384 + hw * 96 : (const bf16*)(ws + WS_QC) + (size_t)tq * 256 + hw * 64);
#pragma unroll
        for (int s = 0; s < NS; ++s) qf[s] = *(const bf16x8*)(qrow + 16 * s + 8 * hh);
    }
    const int kc0 = n - NPREV < 0 ? 0 : n - NPREV;
    const bf16* kg = KIND == 0 ? (const bf16*)(ws + WS_KA) + kvh * 64 : (KIND == 1 ? (const bf16*)(ws + WS_KBN) : (const bf16*)(ws + WS_KC));
    const bf16* vg = KIND == 0 ? (const bf16*)(ws + WS_VA) + kvh * 64 : (KIND == 1 ? (const bf16*)(ws + WS_VB) : (const bf16*)(ws + WS_VC));
    constexpr int PITCH = KIND == 0 ? 128 : 256;
    constexpr int NPC = KIND == 0 ? 2 : 8;
    const int prow = lane >> 3;
    auto issue = [&](int kc, int buf) {
        LAS unsigned char* bb = lds + buf * BUFB;
        const size_t rowbase = (size_t)(tok0 + kc * 64);
#pragma unroll
        for (int j = 0; j < NPC; ++j) {
            const int pc = wave * NPC + j;
            if (KIND == 0) { const int arr = pc >> 3, g = pc & 7; const int pch = ((lane & 7) ^ swz8(g * 8 + prow)) * 8;
                __builtin_amdgcn_global_load_lds((const unsigned*)((arr ? vg : kg) + (rowbase + g * 8 + prow) * PITCH + pch), (LAS unsigned*)(bb + arr * 32768 + g * 1024), 16, 0, 0); }
            else { const int arr = pc >> 5, hd = (pc >> 3) & 3, g = pc & 7; const int pch = ((lane & 7) ^ swz8(g * 8 + prow)) * 8;
                __builtin_amdgcn_global_load_lds((const unsigned*)((arr ? vg : kg) + (rowbase + g * 8 + prow) * PITCH + hd * 64 + pch), (LAS unsigned*)(bb + arr * 32768 + hd * 8192 + g * 1024), 16, 0, 0); }
        }
        if (KIND == 1) { if (wave < 4) { const int row = wave * 16 + (lane >> 2), c = (lane & 3) ^ ((row >> 2) & 3);
            __builtin_amdgcn_global_load_lds((const unsigned*)((const bf16*)(ws + WS_KPE) + (rowbase + row) * 32 + c * 8), (LAS unsigned*)(bb + 65536 + wave * 1024), 16, 0, 0); } }
    };
    unsigned ka[2][4], kpe[2][2], va[2][4];
    { const int x = swz8(r32);
      const int li = lane & 15, g1 = (lane >> 4) & 1, q = li >> 2, pp = li & 3;
#pragma unroll
      for (int bf = 0; bf < 2; ++bf) { const unsigned bb = (unsigned)(size_t)(lds + bf * BUFB);
#pragma unroll
        for (int s = 0; s < 4; ++s) ka[bf][s] = bb + (unsigned)(kslot * 8192 + r32 * 128 + 16 * ((2 * s + hh) ^ x));
#pragma unroll
        for (int s = 0; s < 2; ++s) kpe[bf][s] = bb + (unsigned)(65536 + r32 * 64 + 16 * ((2 * s + hh) ^ ((r32 >> 2) & 3)));
#pragma unroll
        for (int db = 0; db < 2; ++db)
#pragma unroll
            for (int sec = 0; sec < 2; ++sec) { const int key = 8 * sec + 4 * hh + q; const int chunk = 4 * db + 2 * g1 + (pp >> 1);
                va[bf][db * 2 + sec] = bb + (unsigned)(32768 + kslot * 8192 + key * 128 + 16 * (chunk ^ swz8(key)) + 8 * (pp & 1)); } }
    }
    float m_run = KIND == 0 ? sinks[kvh * 4 + hw] * LOG2E : -1e30f, l_run = 0.f;
    f32x16 o0, o1;
#pragma unroll
    for (int r = 0; r < 16; ++r) { o0[r] = 0.f; o1[r] = 0.f; }
    const int qpos = n * 64 + qh * 32 + r32;
    const unsigned tab0 = (unsigned)(size_t)(lds + TAB_LDS + hw * TABN * 4) + (unsigned)((4 * hh - qpos + OFF) * 4);
    auto tile = [&](const unsigned (&kaB)[4], const unsigned (&kpeB)[2], const unsigned (&vaB)[4], int kc) {
        f32x16 sa, sb;
        if (KIND != 1) {
            const unsigned ta = tab0 + (unsigned)(kc * 64 * 4);
#pragma unroll
            for (int r = 0; r < 16; ++r) { sa[r] = *(const LAS float*)(size_t)(ta + ((r & 3) + 8 * (r >> 2)) * 4); sb[r] = *(const LAS float*)(size_t)(ta + (32 + (r & 3) + 8 * (r >> 2)) * 4); }
        } else {
#pragma unroll
            for (int r = 0; r < 16; ++r) { sa[r] = 0.f; sb[r] = 0.f; }
        }
        if (PROBE == 61) { f32x16 da = sa, db = sb;
#pragma unroll
            for (int s = 0; s < 4; ++s) { const bf16x8 k0 = *(const LAS bf16x8*)(size_t)(kaB[s]), k1 = *(const LAS bf16x8*)(size_t)(kaB[s] + 4096);
                da = __builtin_amdgcn_mfma_f32_32x32x16_bf16(k0, qf[s], da, 0, 0, 0); db = __builtin_amdgcn_mfma_f32_32x32x16_bf16(k1, qf[s], db, 0, 0, 0); }
            asm volatile("" :: "v"(da), "v"(db)); }
#pragma unroll
        for (int s = 0; s < 4; ++s) { const bf16x8 k0 = *(const LAS bf16x8*)(size_t)(kaB[s]), k1 = *(const LAS bf16x8*)(size_t)(kaB[s] + 4096);
            sa = __builtin_amdgcn_mfma_f32_32x32x16_bf16(k0, qf[s], sa, 0, 0, 0); sb = __builtin_amdgcn_mfma_f32_32x32x16_bf16(k1, qf[s], sb, 0, 0, 0); }
        if (KIND == 1) {
#pragma unroll
            for (int s = 0; s < 2; ++s) { const bf16x8 k0 = *(const LAS bf16x8*)(size_t)(kpeB[s]), k1 = *(const LAS bf16x8*)(size_t)(kpeB[s] + 2048);
                sa = __builtin_amdgcn_mfma_f32_32x32x16_bf16(k0, qf[4 + s], sa, 0, 0, 0); sb = __builtin_amdgcn_mfma_f32_32x32x16_bf16(k1, qf[4 + s], sb, 0, 0, 0); }
        }
        float bm = fmaxf(sa[0], sb[0]);
#pragma unroll
        for (int r = 1; r < 16; ++r) bm = fmaxf(bm, fmaxf(sa[r], sb[r]));
        bm = pair_max(bm);
        const float m_new = fmaxf(m_run, bm), alpha = __builtin_amdgcn_exp2f(m_run - m_new);
        const bool grow = __any(m_new > m_run);
        m_run = m_new;
        float psum = 0.f; unsigned pka[8], pkb[8];
#pragma unroll
        for (int r = 0; r < 16; r += 2) {
            const float p0 = __builtin_amdgcn_exp2f(sa[r] - m_new), p1 = __builtin_amdgcn_exp2f(sa[r + 1] - m_new), p2 = __builtin_amdgcn_exp2f(sb[r] - m_new), p3 = __builtin_amdgcn_exp2f(sb[r + 1] - m_new);
            psum += (p0 + p1) + (p2 + p3); pka[r >> 1] = cvtpk(p0, p1); pkb[r >> 1] = cvtpk(p2, p3); }
        l_run = l_run * alpha + psum;
        if (PROBE == 62) { float ps2 = 0.f; float mm = m_new; asm volatile("" : "+v"(mm));
#pragma unroll
            for (int r = 0; r < 16; ++r) { const float p0 = __builtin_amdgcn_exp2f(sa[r] - mm), p2 = __builtin_amdgcn_exp2f(sb[r] - mm); ps2 += p0 + p2; asm volatile("" :: "v"(cvtpk(p0, p2))); }
            asm volatile("" :: "v"(ps2)); }
        if (grow) {
#pragma unroll
            for (int r = 0; r < 16; ++r) { o0[r] *= alpha; o1[r] *= alpha; }
        }
#define ATT_VTR(dst, addr, off) asm volatile("ds_read_b64_tr_b16 %0, %1 offset:%c2" : "=&v"(dst) : "v"(addr), "i"(off) : "memory")
#pragma unroll
        for (int half = 0; half < 2; ++half) {
            s16x4 lo0[2], hi0[2], lo1[2], hi1[2];
#pragma unroll
            for (int k2 = 0; k2 < 2; ++k2) {
                if (half == 0 && k2 == 0) { ATT_VTR(lo0[0], vaB[0], 0); ATT_VTR(hi0[0], vaB[1], 0); ATT_VTR(lo1[0], vaB[2], 0); ATT_VTR(hi1[0], vaB[3], 0); }
                if (half == 0 && k2 == 1) { ATT_VTR(lo0[1], vaB[0], 2048); ATT_VTR(hi0[1], vaB[1], 2048); ATT_VTR(lo1[1], vaB[2], 2048); ATT_VTR(hi1[1], vaB[3], 2048); }
                if (half == 1 && k2 == 0) { ATT_VTR(lo0[0], vaB[0], 4096); ATT_VTR(hi0[0], vaB[1], 4096); ATT_VTR(lo1[0], vaB[2], 4096); ATT_VTR(hi1[0], vaB[3], 4096); }
                if (half == 1 && k2 == 1) { ATT_VTR(lo0[1], vaB[0], 6144); ATT_VTR(hi0[1], vaB[1], 6144); ATT_VTR(lo1[1], vaB[2], 6144); ATT_VTR(hi1[1], vaB[3], 6144); }
            }
            asm volatile("s_waitcnt lgkmcnt(0)" ::: "memory"); __builtin_amdgcn_sched_barrier(0);
            const unsigned* pk = half == 0 ? pka : pkb;
#pragma unroll
            for (int k2 = 0; k2 < 2; ++k2) {
                const bf16x8 pb = __builtin_bit_cast(bf16x8, (u32x4){pk[4 * k2], pk[4 * k2 + 1], pk[4 * k2 + 2], pk[4 * k2 + 3]});
                const bf16x8 v0 = (bf16x8){lo0[k2][0], lo0[k2][1], lo0[k2][2], lo0[k2][3], hi0[k2][0], hi0[k2][1], hi0[k2][2], hi0[k2][3]};
                const bf16x8 v1 = (bf16x8){lo1[k2][0], lo1[k2][1], lo1[k2][2], lo1[k2][3], hi1[k2][0], hi1[k2][1], hi1[k2][2], hi1[k2][3]};
                o0 = __builtin_amdgcn_mfma_f32_32x32x16_bf16(v0, pb, o0, 0, 0, 0);
                o1 = __builtin_amdgcn_mfma_f32_32x32x16_bf16(v1, pb, o1, 0, 0, 0);
                if (PROBE == 63) { f32x16 d0 = o0, d1 = o1; d0 = __builtin_amdgcn_mfma_f32_32x32x16_bf16(v1, pb, d0, 0, 0, 0); d1 = __builtin_amdgcn_mfma_f32_32x32x16_bf16(v0, pb, d1, 0, 0, 0); asm volatile("" :: "v"(d0), "v"(d1)); }
            }
        }
#undef ATT_VTR
    };
    issue(kc0, 0);
    asm volatile("s_waitcnt vmcnt(0) lgkmcnt(0)" ::: "memory"); __builtin_amdgcn_s_barrier(); asm volatile("" ::: "memory");
#define ATT_STEP_WAIT() do { if (bg.fly >= 0) asm volatile("s_waitcnt vmcnt(8) lgkmcnt(0)" ::: "memory"); else asm volatile("s_waitcnt vmcnt(0) lgkmcnt(0)" ::: "memory"); \
        __builtin_amdgcn_s_barrier(); asm volatile("" ::: "memory"); } while (0)
    for (int kc = kc0; kc <= n; kc += 2) {
        bgc::step_finish(bg, lyr, lds, ws);
        if (kc < n) issue(kc + 1, 1);
        if (PROBE == 64 && kc < n) issue(kc + 1, 1);
        asm volatile("" ::: "memory"); bgc::step_issue(bg, lyr, lds, ws); asm volatile("" ::: "memory");
        tile(ka[0], kpe[0], va[0], kc);
        ATT_STEP_WAIT();
        if (kc + 1 > n) break;
        bgc::step_finish(bg, lyr, lds, ws);
        if (kc + 1 < n) issue(kc + 2, 0);
        if (PROBE == 64 && kc + 1 < n) issue(kc + 2, 0);
        asm volatile("" ::: "memory"); bgc::step_issue(bg, lyr, lds, ws); asm volatile("" ::: "memory");
        tile(ka[1], kpe[1], va[1], kc + 1);
        ATT_STEP_WAIT();
    }
#undef ATT_STEP_WAIT
    float l_tot = pair_sum(l_run);
    if (KIND == 0) l_tot += __builtin_amdgcn_exp2f(sinks[kvh * 4 + hw] * LOG2E - m_run);
    const float inv = 1.0f / l_tot;
    const int slot = KIND == 0 ? kvh * 4 + hw : (KIND == 1 ? 8 + hw : 12 + hw);
    bf16* orow = (bf16*)(ws + WS_O) + (size_t)tq * D + slot * 64;
    float ss = 0.f;
#pragma unroll
    for (int g = 0; g < 4; ++g) {
        const float a0 = o0[4 * g] * inv, a1 = o0[4 * g + 1] * inv, a2 = o0[4 * g + 2] * inv, a3 = o0[4 * g + 3] * inv;
        const float c0 = o1[4 * g] * inv, c1 = o1[4 * g + 1] * inv, c2 = o1[4 * g + 2] * inv, c3 = o1[4 * g + 3] * inv;
        ss += (a0 * a0 + a1 * a1) + (a2 * a2 + a3 * a3) + (c0 * c0 + c1 * c1) + (c2 * c2 + c3 * c3);
        u32x2 w0; w0.x = cvtpk(a0, a1); w0.y = cvtpk(a2, a3); *(u32x2*)(orow + 8 * g + 4 * hh) = w0;
        u32x2 w1; w1.x = cvtpk(c0, c1); w1.y = cvtpk(c2, c3); *(u32x2*)(orow + 32 + 8 * g + 4 * hh) = w1;
    }
    ss = pair_sum(ss);
    if (hh == 0) ((float*)(ws + WS_OSS))[(size_t)tq * 16 + slot] = ss;
}

template <int KIND>
__device__ __forceinline__ void build_table(LAS unsigned char* lds, int kvh, const float* t5, const float* crel) {
    constexpr int TABN = KIND == 0 ? 256 : 640, OFF = KIND == 0 ? 191 : 575;
    const int tid = hidden_tid();
    for (int i = tid; i < 4 * TABN; i += NTHREADS) {
        const int h = i / TABN, e = i % TABN, rel = e - OFF; float v;
        if (KIND == 0) v = t5[t5_bucket(rel) * 8 + kvh * 4 + h];
        else { int dist = -rel; dist = dist < -63 ? -63 : (dist > 256 ? 256 : dist); v = crel[(dist + 63) * 4 + h]; }
        *(LAS float*)(lds + TAB_LDS + i * 4) = v * LOG2E;
    }
}

__device__ __forceinline__ void phase(LAS unsigned char* lds, unsigned char* ws, unsigned* ctl, int layer, const float* sinks, const float* t5, const float* crel) {
    volatile LAS int* qslot = (volatile LAS int*)(lds + LDS_BYTES - 64);
    int tabkind = -1;
    const int lyr = layer >> 1, gwv = (int)blockIdx.x * NWAVES + __builtin_amdgcn_readfirstlane(hidden_tid() >> 6);
    bgc::State bg; bgc::init(bg, gwv, (int)gridDim.x * NWAVES);
    for (bool first = true;; first = false) {
        if (hidden_tid() == 0) qslot[0] = first ? (int)blockIdx.x : (int)gridDim.x + (int)__hip_atomic_fetch_add(ctl + CW_QUEUE + 64 * layer, 1u, __ATOMIC_RELAXED, __HIP_MEMORY_SCOPE_AGENT);
        __syncthreads();
        const int u = __builtin_amdgcn_readfirstlane(qslot[0]);
        __syncthreads();
        if (u >= 1024) break;
        if (u < 256) { const int n = 31 - (u >> 3), b = u & 7; tabkind = -1; unit<1>(lds, ws, b, n, 0, sinks, bg, lyr); }
        else if (u < 512) { const int v = u - 256, n = 31 - (v >> 3), b = v & 7;
            if (tabkind != 2) { build_table<2>(lds, 0, t5, crel); tabkind = 2; __syncthreads(); }
            unit<2>(lds, ws, b, n, 0, sinks, bg, lyr); }
        else { const int v = u - 512, kvh = v & 1, b = (v >> 1) & 7, n = 31 - (v >> 4);
            if (tabkind != kvh) { build_table<0>(lds, kvh, t5, crel); tabkind = kvh; __syncthreads(); }
            unit<0>(lds, ws, b, n, kvh, sinks, bg, lyr); }
    }
    bgc::step_finish(bg, lyr, lds, ws);
    if ((hidden_tid() & 63) == 0) ((int*)(ws + WS_TOPI))[gwv] = bg.next;
}
}

#define NREP(slot) (PROBE == (slot) ? 2 : 1)
template <unsigned MASK> __global__ void __launch_bounds__(NTHREADS, 2) fwd(Params p) {
    extern __shared__ __attribute__((aligned(16))) unsigned char lds_raw[];
    LAS unsigned char* lds = (LAS unsigned char*)lds_raw;
    const int G = gridDim.x, bid = blockIdx.x, NGW = G * NWAVES;
#define PHASE_LOCALS const int tid = hidden_tid(); const int lane = tid & 63; const int wave = __builtin_amdgcn_readfirstlane(tid >> 6); const int gw = bid * NWAVES + wave; (void)lane; (void)gw;
    unsigned char* ws = p.ws;
    unsigned* ctl = (unsigned*)(ws + WS_CTL);
    volatile LAS unsigned* MISC = (volatile LAS unsigned*)(lds + LDS_BYTES - 128);
    if (threadIdx.x < 32) MISC[threadIdx.x] = 0u;
    if (threadIdx.x == 0) {
#pragma unroll
        for (int i = 0; i < 27; ++i) { const unsigned long long a = (unsigned long long)p.in[i]; *(LAS u32x2*)(lds + PTAB_OFF + i * 8) = (u32x2){(unsigned)a, (unsigned)(a >> 32)}; }
    }
    __syncthreads();
#define PIN(i) ld_in(lds, (i))
    XcdBarrier bar; bar.bar = ctl + CW_BAR; bar.x = 0; bar.st = nullptr;
    if (MK_ONE_LAUNCH) bar = xcd_barrier_post(ctl + CW_BAR, MISC + 8);
    const int lo = p.ph_lo, hi = p.ph_hi;
#define IN(k) (lo <= (k) && (k) < hi)
#define SEAM(k) do { if (MK_ONE_LAUNCH && (k) + 1 < hi) { xcd_barrier_impl(bar.bar, bar.x, bar.st); if (PROBE == 99) xcd_barrier_impl(bar.bar, bar.x, bar.st); } } while (0)
#define RSTD ((float*)(ws + WS_RSTD))
#define SS1 ((float*)(ws + WS_SS1))
#define GATE ((float*)(ws + WS_GATE))
#define LIST ((int*)(ws + WS_LIST))
#define XB ((bf16*)(ws + WS_XB))
#define OB ((bf16*)(ws + WS_O))
#define YB ((bf16*)(ws + WS_Y))
#define X1 ((bf16*)(ws + WS_X1))
    float* XOUT = p.out;

    if (((MASK >> 15) & 1) && IN(0)) {
        PHASE_LOCALS
        for (int rep = 0; rep < NREP(15); ++rep) p0_convert(lds, ws, gw, NGW, wave, lane);
    }
    for (int l = 0; l < NLAYER + 1; ++l) {
        const int PB = 1 + 16 * l;
        if (((MASK >> 0) & 1) && IN(PB + 0)) {
            PHASE_LOCALS
            const float* xin = PIN(I_X);
            for (int rep = 0; rep < NREP(0); ++rep) {
              if (l == 0) {
                for (int t0 = gw; t0 < T; t0 += 2 * NGW) {
                    const int t1 = t0 + NGW < T ? t0 + NGW : t0;
                    f32x4 v[2][4];
#pragma unroll
                    for (int r = 0; r < 2; ++r)
#pragma unroll
                        for (int j = 0; j < 4; ++j) v[r][j] = __builtin_nontemporal_load((const f32x4*)(xin + (size_t)(r ? t1 : t0) * D + 256 * j + 4 * lane));
#pragma unroll
                    for (int r = 0; r < 2; ++r) { const int t = r ? t1 : t0; float ss = 0.f;
#pragma unroll
                        for (int j = 0; j < 4; ++j) { const int c = 256 * j + 4 * lane;
                            ss += (v[r][j].x * v[r][j].x + v[r][j].y * v[r][j].y) + (v[r][j].z * v[r][j].z + v[r][j].w * v[r][j].w);
                            uint2 o; o.x = pk2(v[r][j].x, v[r][j].y); o.y = pk2(v[r][j].z, v[r][j].w); *(uint2*)(XB + (size_t)t * D + c) = o; }
                        ss = wave_sum(ss);
                        if (lane == 0) RSTD[t] = 1.0f / sqrtf(ss * (1.0f / D) + EPS);
                    }
                }
              } else {
                for (int t0 = gw; t0 < T; t0 += 2 * NGW) {
                    const int t1 = t0 + NGW < T ? t0 + NGW : t0;
                    f32x4 v[2][4]; unsigned y[2][4][4];
#pragma unroll
                    for (int r = 0; r < 2; ++r) { const int t = r ? t1 : t0;
#pragma unroll
                        for (int j = 0; j < 4; ++j) { const int c = 256 * j + 4 * lane;
                            { const u32x2 xw = __builtin_nontemporal_load((const u32x2*)(X1 + (size_t)t * D + c)); v[r][j] = (f32x4){bflo(xw.x), bfhi(xw.x), bflo(xw.y), bfhi(xw.y)}; }
#pragma unroll
                            for (int k = 0; k < 4; ++k) y[r][j][k] = __builtin_nontemporal_load((const unsigned*)((const unsigned char*)YB + ((size_t)t * 4 + k) * D + c)); } }
#pragma unroll
                    for (int r = 0; r < 2; ++r) { const int t = r ? t1 : t0; float ss = 0.f;
#pragma unroll
                        for (int j = 0; j < 4; ++j) { const int c = 256 * j + 4 * lane;
                            f32x4 ys = (f32x4){0.f, 0.f, 0.f, 0.f};
#pragma unroll
                            for (int k = 0; k < 4; ++k) { const auto lo2 = __builtin_amdgcn_cvt_pk_f32_fp8((int)y[r][j][k], false), hi2 = __builtin_amdgcn_cvt_pk_f32_fp8((int)y[r][j][k], true);
                                ys.x += lo2[0]; ys.y += lo2[1]; ys.z += hi2[0]; ys.w += hi2[1]; }
                            v[r][j] = v[r][j] + ys * Y8INV;
                            ss += (v[r][j].x * v[r][j].x + v[r][j].y * v[r][j].y) + (v[r][j].z * v[r][j].z + v[r][j].w * v[r][j].w);
                            if (l == NLAYER) *(f32x4*)(XOUT + (size_t)t * D + c) = v[r][j];
                            if (l < NLAYER) { uint2 o; o.x = pk2(v[r][j].x, v[r][j].y); o.y = pk2(v[r][j].z, v[r][j].w); *(uint2*)(XB + (size_t)t * D + c) = o; }
                        }
                        ss = wave_sum(ss);
                        if (lane == 0 && l < NLAYER) RSTD[t] = 1.0f / sqrtf(ss * (1.0f / D) + EPS);
                    }
                }
              }
            }
            SEAM(PB + 0);
        }
        if (l == NLAYER) break;
        if (((MASK >> 1) & 1) && IN(PB + 1)) {
            PHASE_LOCALS
            fg::CfgG1 cfg; cfg.S.init(T, 2048, G, bid); cfg.A = XB; cfg.Bt = (const bf16*)(ws + WS_WIN) + (size_t)l * 2048 * 1024; cfg.ws = ws; cfg.rstd = RSTD;
            cfg.aqn = PIN(I_AQN) + l * 64; cfg.akn = PIN(I_AKN) + l * 64; cfg.cqn = PIN(I_CQN) + l * 64; cfg.ckn = PIN(I_CKN) + l * 64; cfg.bkn = PIN(I_BKN) + l * 96;
            for (int rep = 0; rep < NREP(1); ++rep) fg::gemm_phase(lds, cfg);
            SEAM(PB + 1);
        }
        if (((MASK >> 4) & 1) && IN(PB + 4)) {
            PHASE_LOCALS
            fg::CfgGB cfg; cfg.G = G; cfg.c = bid; cfg.layer = l; cfg.ws = ws; cfg.bqn = PIN(I_BQN) + l * 96; cfg.bkn = PIN(I_BKN) + l * 96;
            for (int rep = 0; rep < NREP(4); ++rep) fg::gemm_phase(lds, cfg);
            SEAM(PB + 4);
        }
        if (((MASK >> 6) & 1) && IN(PB + 6)) {
            PHASE_LOCALS
            const float* t5 = PIN(I_T5); const float* sinks = PIN(I_ASINK) + l * 8; const float* crel = PIN(I_CREL) + (size_t)l * 320 * 4;
            for (int rep = 0; rep < NREP(6); ++rep) att::phase(lds, ws, ctl, l * 2 + rep, sinks, t5, crel);
            SEAM(PB + 6);
        }
        if (((MASK >> 8) & 1) && IN(PB + 8)) {
            PHASE_LOCALS
            fg::CfgG2 cfg; cfg.S.init(T, 1024, G, bid); cfg.A = OB; cfg.Bt = (const bf16*)(ws + WS_WOUT) + (size_t)l * 1024 * 1024; cfg.ws = ws;
            cfg.xin = XB; cfg.xout = X1; cfg.fgain = PIN(I_FFN_NORM) + l * D;
            for (int rep = 0; rep < NREP(8); ++rep) fg::gemm_phase(lds, cfg);
            SEAM(PB + 8);
        }
        if (((MASK >> 10) & 1) && IN(PB + 10)) {
            PHASE_LOCALS
            const float* br = PIN(I_BR) + l * NEXP;
            LAS float* lg = (LAS float*)(lds);
            LAS int* pe = (LAS int*)(lds + 65536);
            const bf16* wr2 = (const bf16*)(ws + WS_WR2) + (size_t)l * 32 * 2 * 2 * 64 * 8;
            for (int rep = 0; rep < NREP(10); ++rep)
            for (int tb = bid * 64; tb < T; tb += G * 64) {
                {
                    const int tg = wave >> 1, eh = wave & 1, tok = tb + 16 * tg + (lane & 15), kq = lane >> 4;
                    const bf16* xp = X1 + (size_t)tok * D + 8 * kq; const bf16* wp = wr2 + ((size_t)eh * 128 + lane) * 8;
                    f32x4 acc = (f32x4){0.f, 0.f, 0.f, 0.f};
#pragma unroll 1
                    for (int j0 = 0; j0 < 32; j0 += 16) {
                        bf16x8 aw[16], bh[16], bm[16];
#pragma unroll
                        for (int q = 0; q < 16; ++q) { aw[q] = *(const bf16x8*)(xp + 32 * (j0 + q)); bh[q] = *(const bf16x8*)(wp + (size_t)(j0 + q) * 2048); bm[q] = *(const bf16x8*)(wp + (size_t)(j0 + q) * 2048 + 512); }
                        __builtin_amdgcn_sched_barrier(0);
#pragma unroll
                        for (int q = 0; q < 16; ++q) { acc = __builtin_amdgcn_mfma_f32_16x16x32_bf16(aw[q], bh[q], acc, 0, 0, 0); acc = __builtin_amdgcn_mfma_f32_16x16x32_bf16(aw[q], bm[q], acc, 0, 0, 0); }
                    }
#pragma unroll
                    for (int r = 0; r < 4; ++r) lg[(16 * tg + (lane >> 4) * 4 + r) * 32 + 16 * eh + (lane & 15)] = acc[r];
                }
                __syncthreads();
                float svp[4];
#pragma unroll
                for (int it = 0; it < 4; ++it) { const int t = tb + wave * 8 + it * 2 + (lane >> 5), e = lane & 31; svp[it] = e < 16 ? SS1[(size_t)t * 16 + e] : 0.f; }
                const float bre = br[lane & 31];
#pragma unroll
                for (int it = 0; it < 4; ++it) {
                    const int tl = wave * 8 + it * 2 + (lane >> 5), t = tb + tl, e = lane & 31;
                    float sv = svp[it];
                    sv += xor_f<1>(sv); sv += xor_f<2>(sv); sv += xor_f<4>(sv); sv += xor_f<8>(sv); sv += xor_f<16>(sv);
                    const float rs = 1.0f / sqrtf(sv * (1.f / D) + EPS);
                    if (e == 0) RSTD[t] = rs;
                    float lv = lg[tl * 32 + e] * rs + bre; int ti[4]; float tv[4];
#pragma unroll
                    for (int r = 0; r < 4; ++r) {
                        float bv = lv; int bi = e;
#define TOPK_STEP(O) { const float ov = xor_f<O>(bv); const int oi = xor_i<O>(bi); if (ov > bv || (ov == bv && oi < bi)) { bv = ov; bi = oi; } }
                        TOPK_STEP(1) TOPK_STEP(2) TOPK_STEP(4) TOPK_STEP(8) TOPK_STEP(16)
#undef TOPK_STEP
                        ti[r] = bi; tv[r] = bv; if (e == bi) lv = -3.0e38f;
                    }
                    const float e0 = 1.f, e1 = expf(tv[1] - tv[0]), e2 = expf(tv[2] - tv[0]), e3 = expf(tv[3] - tv[0]); const float inv = 1.0f / (e0 + e1 + e2 + e3);
                    if (e == 0) { *(f32x4*)(GATE + (size_t)t * 4) = (f32x4){e0 * inv, e1 * inv, e2 * inv, e3 * inv};
                        const int lp = tl * 4; pe[lp] = ti[0]; pe[lp + 1] = ti[1]; pe[lp + 2] = ti[2]; pe[lp + 3] = ti[3]; }
                }
                __syncthreads();
                LAS int* wcnt = (LAS int*)(lds + 65536 + 1024);
                LAS int* gbase = (LAS int*)(lds + 65536 + 1536);
                int myexp = 0, myrank = 0;
                if (tid < 256) {
                    myexp = pe[tid]; int cntx = 0;
                    for (int x = 0; x < 32; ++x) { const unsigned long long mk = __ballot(myexp == x);
                        if (myexp == x) myrank = (int)__builtin_amdgcn_mbcnt_hi((unsigned)(mk >> 32), __builtin_amdgcn_mbcnt_lo((unsigned)mk, 0u));
                        if (lane == x) cntx = __builtin_popcountll(mk); }
                    if (lane < 32) wcnt[wave * 32 + lane] = cntx;
                }
                __syncthreads();
                if (tid < 32) { const int c = (wcnt[tid] + wcnt[32 + tid]) + (wcnt[64 + tid] + wcnt[96 + tid]);
                    gbase[tid] = (int)__hip_atomic_fetch_add(ctl + CW_CNT + ((l * 2 + rep) * 32 + tid) * 64, (unsigned)c, __ATOMIC_RELAXED, __HIP_MEMORY_SCOPE_AGENT); }
                __syncthreads();
                if (tid < 256) { int pos = gbase[myexp] + myrank; for (int w = 0; w < wave; ++w) pos += wcnt[w * 32 + myexp];
                    (LIST + (size_t)rep * NEXP * LIST_CAP)[(size_t)myexp * LIST_CAP + pos] = (tb + (tid >> 2)) * 4 + (tid & 3); }
                __syncthreads();
            }
        }
        if (((MASK >> 10) & 1) && IN(PB + 10)) {
            PHASE_LOCALS
            { bgc::State bg; bgc::init(bg, gw, NGW); bg.next = __builtin_amdgcn_readfirstlane(((const int*)(ws + WS_TOPI))[gw]);
              for (;;) { bgc::step_finish(bg, l, lds, ws); if (bg.next >= bg.end) break; bgc::step_issue(bg, l, lds, ws); } }
            SEAM(PB + 10);
        }
        if (((MASK >> 11) & 1) && IN(PB + 11)) {
            PHASE_LOCALS
            fg::build_exptab(lds, ctl, l * 2, 8, G, bid);
            fg::CfgMA cfg; cfg.ws = ws; cfg.layer = l; cfg.bgu = PIN(I_BGU) + (size_t)l * NEXP * 2048; cfg.ldsb = lds; cfg.ctl = ctl;
            for (int rep = 0; rep < NREP(11); ++rep) fg::gemm_phase(lds, cfg);
            __syncthreads();
        }
        if (((MASK >> 13) & 1) && IN(PB + 13)) {
            PHASE_LOCALS
            fg::build_exptab(lds, ctl, l * 2, 4, G, (G & 7) == 0 ? (((G >> 3) - 1 - (bid >> 3)) << 3) | (bid & 7) : G - 1 - bid);
            fg::CfgMB cfg; cfg.ws = ws; cfg.layer = l; cfg.bdn = PIN(I_BDN) + (size_t)l * NEXP * D; cfg.ldsb = lds; cfg.ctl = ctl;
            for (int rep = 0; rep < NREP(13); ++rep) fg::gemm_phase(lds, cfg);
            SEAM(PB + 13);
        }
    }
#undef IN
#undef SEAM
}

template <unsigned MASK> static void launch_one(int grid, hipStream_t stream, const Params& p) {
    static bool attr_done = false;
    if (!attr_done) { (void)hipFuncSetAttribute((const void*)fwd<MASK>, hipFuncAttributeMaxDynamicSharedMemorySize, LDS_BYTES); attr_done = true; }
    hipLaunchKernelGGL(fwd<MASK>, dim3(grid), dim3(NTHREADS), LDS_BYTES, stream, p);
}
extern "C" void kernel_launch(void* const* d_in, const int* in_sizes, int n_in, void* d_out, int out_size, void* d_ws, size_t ws_size, hipStream_t stream) {
    static int grid = 0;
    if (grid == 0) {
        if (n_in != 27 || out_size != T * D || ws_size < WS_END) { fprintf(stderr, "kernel_launch: unexpected shapes: n_in %d out %d ws %zu\n", n_in, out_size, ws_size); grid = -1; return; }
        int dev = 0, cus = 0;
        if (hipGetDevice(&dev) != hipSuccess || hipDeviceGetAttribute(&cus, hipDeviceAttributeMultiprocessorCount, dev) != hipSuccess) { grid = -1; return; }
        grid = cus;
    }
    if (grid < 0) return;
    (void)hipMemsetAsync((char*)d_ws + WS_CTL, 0, CTL_ZERO_BYTES, stream);
    Params p{};
    for (int i = 0; i < 27; ++i) p.in[i] = (const float*)d_in[i];
    p.out = (float*)d_out; p.ws = (unsigned char*)d_ws;
    const int NPH = 1 + 16 * NLAYER + 1;
#if MK_ONE_LAUNCH
    p.ph_lo = 0; p.ph_hi = NPH;
    launch_one<0xFFFFu>(grid, stream, p);
#else
    for (int ph = 0; ph < NPH; ++ph) {
        const int s = ph == 0 ? 15 : (ph - 1) % 16;
        if (!(s == 15 ? ph == 0 : (s == 0 || s == 1 || s == 4 || s == 6 || s == 8 || s == 10 || s == 11 || s == 13))) continue;
        p.ph_lo = ph; p.ph_hi = ph + 1;
        switch (s) {
            case 0: launch_one<1u << 0>(grid, stream, p); break;   case 1: launch_one<1u << 1>(grid, stream, p); break;
            case 4: launch_one<1u << 4>(grid, stream, p); break;   case 6: launch_one<1u << 6>(grid, stream, p); break;
            case 8: launch_one<1u << 8>(grid, stream, p); break;   case 10: launch_one<1u << 10>(grid, stream, p); break;
            case 11: launch_one<1u << 11>(grid, stream, p); break; case 13: launch_one<1u << 13>(grid, stream, p); break;
            case 15: launch_one<1u << 15>(grid, stream, p); break;
        }
    }
#endif
}
```

```cpp
#include <hip/hip_runtime.h>
#include <cstdio>
#include <cstdint>

#ifndef PROBE
#define PROBE -1
#endif
#ifndef MK_ONE_LAUNCH
#define MK_ONE_LAUNCH 1
#endif

#define GAS __attribute__((address_space(1)))
#define LAS __attribute__((address_space(3)))
typedef unsigned short bf16;
typedef float f32x4 __attribute__((ext_vector_type(4)));
typedef short bf16x8 __attribute__((ext_vector_type(8)));
typedef unsigned u32x4 __attribute__((ext_vector_type(4)));
typedef unsigned u32x2 __attribute__((ext_vector_type(2)));
typedef int i32x4 __attribute__((ext_vector_type(4)));

constexpr int T = 16384, SEQ = 2048, NBATCH = 8, D = 1024, NLAYER = 2, CHUNK = 64, NCH = 32;
constexpr int IN_W = 1952, NEXP = 32, TOPK = 4, DEXP = 1024;
constexpr float EPS = 1e-6f, LOG2E = 1.4426950408889634f;
constexpr float QSCALE_AC = 0.125f * LOG2E;
constexpr float QSCALE_B = 0.10206207261596575f * LOG2E;
constexpr int NROWS_MAX = (256 + 32) * 256;
constexpr int LIST_CAP = 16384;

constexpr size_t MiB = 1u << 20;
constexpr size_t WS_CTL = 0, CTL_ZERO_BYTES = 256 * 1024;
constexpr size_t WS_RSTD = 18 * MiB, WS_OSS = 19 * MiB, WS_SS1 = 20 * MiB, WS_TOPI = 21 * MiB, WS_GATE = 22 * MiB, WS_LIST = 24 * MiB;
constexpr size_t WS_XB = 32 * MiB, WS_QA = 64 * MiB, WS_KA = 80 * MiB, WS_VA = 84 * MiB, WS_QC = 88 * MiB, WS_KC = 96 * MiB, WS_VC = 104 * MiB;
constexpr size_t WS_BRAW = 112 * MiB, WS_QB = 128 * MiB, WS_KBN = 144 * MiB, WS_VB = 152 * MiB, WS_KPE = 160 * MiB, WS_O = 176 * MiB;
constexpr size_t WS_WR2 = 16 * MiB;
constexpr size_t WS_WB = 14 * MiB;
constexpr size_t WS_ROPE = 17 * MiB, WS_BSS = 23 * MiB;
constexpr size_t WS_WIN = 2 * MiB, WS_WOUT = 10 * MiB;
constexpr size_t WS_WGU = 256 * MiB, WS_WDN = 512 * MiB;
constexpr size_t WS_ACT = 640 * MiB, WS_Y = 800 * MiB;
constexpr size_t WS_X1 = 944 * MiB;
constexpr size_t WS_XB8 = 208 * MiB;
constexpr float W8SCALE = 64.0f, W8INV = 1.0f / 64.0f;
constexpr float Y8SCALE = 16.0f, Y8INV = 1.0f / 16.0f;
constexpr size_t WS_SCR = 1024 * MiB;
constexpr size_t WS_END = 1024 * MiB;
constexpr int CW_BAR = 4096;
constexpr int CW_MOE = 32768;
constexpr int CW_TMO = 8;
constexpr int CW_CNT = 16384;

constexpr int LDS_BYTES = 163840;
constexpr int NWAVES = 8, NTHREADS = 512;

__device__ __forceinline__ unsigned f2bf(float f) { unsigned u = __builtin_bit_cast(unsigned, f); return (u + 0x7fffu + ((u >> 16) & 1u)) >> 16; }
__device__ __forceinline__ unsigned pk2(float lo, float hi) { return f2bf(lo) | (f2bf(hi) << 16); }
__device__ __forceinline__ float bf2f(unsigned short b) { return __builtin_bit_cast(float, ((unsigned)b) << 16); }
__device__ __forceinline__ float bflo(unsigned w) { return __builtin_bit_cast(float, w << 16); }
__device__ __forceinline__ float bfhi(unsigned w) { return __builtin_bit_cast(float, w & 0xffff0000u); }
template <int O> __device__ __forceinline__ float xor_f(float v) { static_assert(O >= 1 && O < 32, "xor mask"); return __builtin_bit_cast(float, __builtin_amdgcn_ds_swizzle(__builtin_bit_cast(int, v), (O << 10) | 0x1f)); }
template <int O> __device__ __forceinline__ int xor_i(int v) { static_assert(O >= 1 && O < 32, "xor mask"); return __builtin_amdgcn_ds_swizzle(v, (O << 10) | 0x1f); }
__device__ __forceinline__ float pair_sum(float v) { const unsigned u = __builtin_bit_cast(unsigned, v); auto rr = __builtin_amdgcn_permlane32_swap(u, u, false, false); return __builtin_bit_cast(float, (unsigned)rr[0]) + __builtin_bit_cast(float, (unsigned)rr[1]); }
__device__ __forceinline__ float pair_max(float v) { const unsigned u = __builtin_bit_cast(unsigned, v); auto rr = __builtin_amdgcn_permlane32_swap(u, u, false, false); return fmaxf(__builtin_bit_cast(float, (unsigned)rr[0]), __builtin_bit_cast(float, (unsigned)rr[1])); }
__device__ __forceinline__ float wave_sum(float v) {
    v += xor_f<1>(v); v += xor_f<2>(v); v += xor_f<4>(v); v += xor_f<8>(v); v += xor_f<16>(v);
    return pair_sum(v);
}
__device__ __forceinline__ unsigned pk4_fp8(float a, float b, float c, float d) { unsigned w = 0u; w = __builtin_amdgcn_cvt_pk_fp8_f32(a, b, w, false); w = __builtin_amdgcn_cvt_pk_fp8_f32(c, d, w, true); return w; }
__device__ __forceinline__ int hidden_tid() { int t = threadIdx.x; asm volatile("" : "+v"(t)); return t; }
constexpr int PTAB_OFF = LDS_BYTES - 512;
__device__ __forceinline__ const float* ld_in(LAS unsigned char* lds, int i) { const u32x2 v = *(const LAS u32x2*)(lds + PTAB_OFF + i * 8);
    const unsigned long long a = ((unsigned long long)(unsigned)__builtin_amdgcn_readfirstlane((int)v.y) << 32) | (unsigned)__builtin_amdgcn_readfirstlane((int)v.x); return (const float*)a; }
__device__ __forceinline__ unsigned ld_agent(const unsigned* p) { return __hip_atomic_load(p, __ATOMIC_RELAXED, __HIP_MEMORY_SCOPE_AGENT); }

#define XB_TMO      128
#define XB_XCNT(j)  (256  + 64 * (j))
#define XB_XSUB(j)  (1280 + 64 * (j))
#define XB_XGEN(j)  (2304 + 64 * (j))
#define XB_TOP      3328
#define XB_TOPGEN   3392
#define XCD_BAR_WORDS 3456
#define XB_SPIN_CAP (1u << 18)
__device__ __forceinline__ unsigned xb_ld(unsigned* p)              { return __hip_atomic_load(p, __ATOMIC_RELAXED, __HIP_MEMORY_SCOPE_AGENT); }
__device__ __forceinline__ unsigned xb_add(unsigned* p, unsigned v) { return __hip_atomic_fetch_add(p, v, __ATOMIC_RELAXED, __HIP_MEMORY_SCOPE_AGENT); }
__device__ __forceinline__ unsigned xb_xcc_id() { return (unsigned)__builtin_amdgcn_s_getreg((3 << 11) | 20) & 0xFu; }
#define XB_SPIN(cond, bar) do { unsigned _sp = 0; while (cond) { __builtin_amdgcn_s_sleep(1); \
    if ((++_sp & 255u) == 0u) { if (xb_ld(&(bar)[XB_TMO])) break; if (_sp > XB_SPIN_CAP) { atomicAdd(&(bar)[XB_TMO], 1u); break; } } } } while (0)
struct XcdBarrier { unsigned* bar; unsigned x; volatile LAS unsigned* st; };
__device__ __forceinline__ XcdBarrier xcd_barrier_post(unsigned* bar, volatile LAS unsigned* st) {
    XcdBarrier b; b.bar = bar; b.x = xb_xcc_id(); b.st = st;
    if (threadIdx.x == 0) (void)xb_add(&bar[XB_XCNT(b.x)], 1u);
    return b;
}
__device__ __forceinline__ void xcd_barrier_complete(unsigned* bar, unsigned x, unsigned& nloc, unsigned& nx) {
    const unsigned G = gridDim.x * gridDim.y * gridDim.z;
    unsigned sum, cnt, mine, sp = 0u;
    for (;;) {
        sum = 0u; cnt = 0u; mine = 0u;
#pragma unroll
        for (unsigned j = 0; j < 16; ++j) { const unsigned c = xb_ld(&bar[XB_XCNT(j)]); sum += c; cnt += (c > 0u) ? 1u : 0u; mine = (j == x) ? c : mine; }
        if (sum == G) break;
        __builtin_amdgcn_s_sleep(1);
        if ((++sp & 255u) == 0u) { if (xb_ld(&bar[XB_TMO])) break; if (sp > XB_SPIN_CAP) { atomicAdd(&bar[XB_TMO], 1u); break; } }
    }
    nloc = mine > 0u ? mine : 1u; nx = cnt > 0u ? cnt : 1u;
}
__device__ __attribute__((noinline)) void xcd_barrier_impl(unsigned* bar, unsigned bx, volatile LAS unsigned* st) {
    XcdBarrier b; b.bar = bar; b.x = bx; b.st = st;
    asm volatile("s_waitcnt vmcnt(0)" ::: "memory");
    __syncthreads();
    if (threadIdx.x == 0) {
        unsigned* bar = b.bar;
        __builtin_amdgcn_s_waitcnt(0);
        unsigned nloc = b.st[0], nx = b.st[1];
        if (nloc == 0u) { xcd_barrier_complete(bar, b.x, nloc, nx); b.st[0] = nloc; b.st[1] = nx; }
        const unsigned old = xb_add(&bar[XB_XSUB(b.x)], 1u);
        const unsigned gen = old / nloc;
        if (old + 1u == (gen + 1u) * nloc) {
            __builtin_amdgcn_fence(__ATOMIC_RELEASE, "agent");
            asm volatile("s_waitcnt vmcnt(0)" ::: "memory");
            const unsigned og = xb_add(&bar[XB_TOP], 1u);
            const unsigned tg = og / nx;
            if (og + 1u == (tg + 1u) * nx) xb_add(&bar[XB_TOPGEN], 1u);
            else XB_SPIN(xb_ld(&bar[XB_TOPGEN]) == tg, bar);
            __builtin_amdgcn_fence(__ATOMIC_ACQUIRE, "agent");
            xb_add(&bar[XB_XGEN(b.x)], 1u);
            asm volatile("s_waitcnt vmcnt(0)" ::: "memory");
        } else {
            XB_SPIN(xb_ld(&bar[XB_XGEN(b.x)]) == gen, bar);
            __builtin_amdgcn_fence(__ATOMIC_ACQUIRE, "agent");
            asm volatile("s_waitcnt vmcnt(0)" ::: "memory");
        }
    }
    __syncthreads();
}

struct Params { const float* in[27]; float* out; unsigned char* ws; int ph_lo, ph_hi; };
enum { I_X = 0, I_ATTN_NORM, I_W_IN, I_AQN, I_AKN, I_ASINK, I_T5, I_BQAN, I_BWQB, I_BKVAN, I_BWKVB, I_BQN, I_BKN, I_CQN, I_CKN, I_CREL,
       I_AON, I_BON, I_CON, I_WOUT, I_FFN_NORM, I_WR, I_BR, I_WGU, I_BGU, I_WDN, I_BDN };

__device__ __forceinline__ int t5_bucket(int rel) {
    const int ret = rel > 0 ? 16 : 0; const int n = rel < 0 ? -rel : rel;
    if (n < 8) return ret + n;
    int large = 2 + (31 - __builtin_clz((unsigned)(n * n)));
    large = large > 15 ? 15 : large;
    return ret + large;
}

__device__ __forceinline__ int g1_colbase(int hh, int bj) {
    int base;
    if (hh < 8) base = hh * 64;
    else if (hh < 10) base = 512 + (hh - 8) * 64;
    else if (hh < 12) base = 640 + (hh - 10) * 64;
    else if (hh < 16) base = 1184 + (hh - 12) * 64;
    else if (hh < 20) base = 1440 + (hh - 16) * 64;
    else if (hh < 24) base = 1696 + (hh - 20) * 64;
    else if (hh < 28) base = 768 + (hh - 24) * 64;
    else if (hh < 30) base = 1024 + (hh - 28) * 64;
    else if (hh == 30) return bj == 0 ? 1152 : -1;
    else return -1;
    return base + 32 * bj;
}
struct CvtItem { const float* W; const float* g1; const float* g2; const float* g3; bf16* dst; int ldw, c0, k0, dpitch, kmax; bool fp8; };
__device__ __forceinline__ void cvt_decode(CvtItem& d, int it, LAS unsigned char* lds, unsigned char* ws) {
    constexpr int N_GU = 32 * 16 * 64, N_DN = 32 * 16 * 32, N_IN = 16 * 64, N_OUT = 16 * 32, N_B = 2 * 4 * 16, N_L = N_GU + N_DN + N_IN + N_OUT + N_B;
    const int l = it / N_L; int r = it - l * N_L;
    d.g1 = nullptr; d.g2 = nullptr; d.g3 = nullptr; d.dpitch = 1024; d.kmax = 1 << 30; d.fp8 = false;
    if (r < N_GU) { const int e = r >> 10, kb = (r >> 6) & 15, g = r & 63; const int pn = g >> 3, bj = (g >> 2) & 1, wc = g & 3;
        d.W = ld_in(lds, I_WGU) + ((size_t)l * NEXP + e) * D * 2048; d.ldw = 2048; d.c0 = bj * 1024 + 128 * pn + 32 * wc; d.k0 = kb * 64;
        d.dst = (bf16*)(ws + WS_WGU + (((size_t)l * NEXP + e) * 2048 + 32 * g) * 1024); d.fp8 = true; return; }
    r -= N_GU;
    if (r < N_DN) { const int e = r >> 9, kb = (r >> 5) & 15, g = r & 31;
        d.W = ld_in(lds, I_WDN) + ((size_t)l * NEXP + e) * D * D; d.ldw = D; d.c0 = 32 * g; d.k0 = kb * 64;
        d.dst = (bf16*)(ws + WS_WDN + (((size_t)l * NEXP + e) * 1024 + 32 * g) * 1024); d.fp8 = true; return; }
    r -= N_DN;
    if (r < N_IN) { const int kb = r >> 6, g = r & 63; const int pn = g >> 3, bj = (g >> 2) & 1, wc = g & 3;
        d.W = ld_in(lds, I_W_IN) + (size_t)l * D * IN_W; d.ldw = IN_W; d.c0 = g1_colbase(pn * 4 + wc, bj); d.g1 = ld_in(lds, I_ATTN_NORM) + l * D; d.k0 = kb * 64;
        d.dst = (bf16*)(ws + WS_WIN) + ((size_t)l * 2048 + 32 * g) * 1024; return; }
    r -= N_IN;
    if (r < N_OUT) { const int kb = r >> 5, g = r & 31;
        d.W = ld_in(lds, I_WOUT) + (size_t)l * D * D; d.ldw = D; d.c0 = 32 * g; d.g1 = ld_in(lds, I_AON) + l * 512; d.g2 = ld_in(lds, I_BON) + l * 256; d.g3 = ld_in(lds, I_CON) + l * 256; d.k0 = kb * 64;
        d.dst = (bf16*)(ws + WS_WOUT) + ((size_t)l * 1024 + 32 * g) * 1024; return; }
    r -= N_OUT;
    {
        const int which = r >> 6, kb = (r >> 4) & 3, g = r & 15; const int pn = g >> 3, bj = (g >> 2) & 1, wc = g & 3;
        if (which == 0) d.c0 = pn == 0 ? wc * 96 + 32 * bj : (bj == 0 ? wc * 96 + 64 : -1); else d.c0 = wc * 128 + 64 * pn + 32 * bj;
        d.dst = (bf16*)(ws + WS_WB) + (((size_t)l * 2 + which) * 512 + 32 * g) * 256; d.dpitch = 256; d.k0 = kb * 64;
        if (which == 0) { d.W = ld_in(lds, I_BWQB) + (size_t)l * 256 * 384; d.ldw = 384; d.g1 = ld_in(lds, I_BQAN) + l * 256; }
        else { d.W = ld_in(lds, I_BWKVB) + (size_t)l * 128 * 512; d.ldw = 512; d.g1 = ld_in(lds, I_BKVAN) + l * 128; d.kmax = 128; }
    }
}
__device__ __forceinline__ void cvt_load(const CvtItem& d, f32x4 (&v)[8], float (&gk)[8], int lane) {
#pragma unroll
    for (int j = 0; j < 8; ++j) {
        const int kk = (lane >> 3) + 8 * j, cq = (lane & 7) * 4, k = d.k0 + kk;
        v[j] = (f32x4){0.f, 0.f, 0.f, 0.f}; gk[j] = 1.f;
        if (d.c0 >= 0 && k < d.kmax) v[j] = __builtin_nontemporal_load((const f32x4*)(d.W + (size_t)k * d.ldw + d.c0 + cq));
        if (d.g1 && k < d.kmax) gk[j] = d.g2 ? (k < 512 ? d.g1[k] : (k < 768 ? d.g2[k - 512] : d.g3[k - 768])) : d.g1[k];
    }
}
__device__ __forceinline__ void cvt_store(const CvtItem& d, const f32x4 (&v)[8], const float (&gk)[8], LAS float* scr, int lane) {
#pragma unroll
    for (int j = 0; j < 8; ++j) { const int kk = (lane >> 3) + 8 * j, cq = (lane & 7) * 4; LAS float* p = scr + kk * 33 + cq;
        p[0] = v[j].x * gk[j]; p[1] = v[j].y * gk[j]; p[2] = v[j].z * gk[j]; p[3] = v[j].w * gk[j]; }
    asm volatile("s_waitcnt lgkmcnt(0)" ::: "memory");
    const int c = lane & 7;
#pragma unroll
    for (int j = 0; j < 4; ++j) {
        const int cc = (lane >> 3) + 8 * j; const LAS float* sp = scr + (8 * c) * 33 + cc;
        const int slot = 16 * ((cc >> 2) & 1) + 4 * (cc >> 3) + (cc & 3);
        if (d.fp8) { u32x2 o; o.x = pk4_fp8(sp[0] * W8SCALE, sp[33] * W8SCALE, sp[66] * W8SCALE, sp[99] * W8SCALE); o.y = pk4_fp8(sp[132] * W8SCALE, sp[165] * W8SCALE, sp[198] * W8SCALE, sp[231] * W8SCALE);
            *(u32x2*)((unsigned char*)d.dst + (size_t)slot * d.dpitch + d.k0 + 8 * c) = o; }
        else { u32x4 o; o.x = pk2(sp[0], sp[33]); o.y = pk2(sp[66], sp[99]); o.z = pk2(sp[132], sp[165]); o.w = pk2(sp[198], sp[231]);
            *(u32x4*)(d.dst + (size_t)slot * d.dpitch + d.k0 + 8 * c) = o; }
    }
    asm volatile("s_waitcnt lgkmcnt(0)" ::: "memory");
}
__device__ __forceinline__ void cvt_range(int first, int count, int small, LAS unsigned char* lds, unsigned char* ws, int gw, int NGW, int wave, int lane) {
    constexpr int NS = 16 * 64 + 16 * 32 + 2 * 4 * 16, NM = 32 * 16 * 64 + 32 * 16 * 32;
#define CVT_MAP(i) (small ? ((i) / NS) * (NM + NS) + NM + (i) % NS : first + (i))
    LAS float* scr = (LAS float*)(lds + wave * 16384);
    CvtItem da, db; f32x4 va[8], vb[8]; float ga[8], gb[8];
    int it = gw;
    if (it < count) { cvt_decode(da, CVT_MAP(it), lds, ws); cvt_load(da, va, ga, lane); }
    while (it < count) {
        const int it1 = it + NGW;
        if (it1 < count) { cvt_decode(db, CVT_MAP(it1), lds, ws); cvt_load(db, vb, gb, lane); }
        cvt_store(da, va, ga, scr, lane);
        if (it1 >= count) break;
        const int it2 = it1 + NGW;
        if (it2 < count) { cvt_decode(da, CVT_MAP(it2), lds, ws); cvt_load(da, va, ga, lane); }
        cvt_store(db, vb, gb, scr, lane);
        it = it2;
    }
}

#define GAS __attribute__((address_space(1)))
namespace bgc {
constexpr int NM_GU = 32 * 16 * 64, NM_DN = 32 * 16 * 32, NM = NM_GU + NM_DN;
constexpr int SCR_OFF = 143360, SCR_BYTES = 2304;
struct State { int next, end, fly, gw, ngw; f32x4 v[8]; };
__device__ __forceinline__ void decode(int f, int l, LAS unsigned char* lds, unsigned char* ws, const float*& src, unsigned char*& dst, int& ldw) {
    if (f < NM_GU) { const int e = f >> 10, kb = (f >> 6) & 15, g32 = f & 63, pn = g32 >> 3, bj = (g32 >> 2) & 1, wc = g32 & 3;
        src = ld_in(lds, I_WGU) + (((size_t)l * NEXP + e) * D + kb * 64) * 2048 + bj * 1024 + 128 * pn + 32 * wc; ldw = 2048;
        dst = ws + WS_WGU + (((size_t)l * NEXP + e) * 2048 + 32 * g32) * 1024 + kb * 64; }
    else { const int r = f - NM_GU; const int e = r >> 9, kb = (r >> 5) & 15, g32 = r & 31;
        src = ld_in(lds, I_WDN) + (((size_t)l * NEXP + e) * D + kb * 64) * D + 32 * g32; ldw = D;
        dst = ws + WS_WDN + (((size_t)l * NEXP + e) * 1024 + 32 * g32) * 1024 + kb * 64; }
}
__device__ __forceinline__ void init(State& s, int gw, int NGW) {
    s.gw = gw; s.ngw = NGW; s.next = 0; s.end = gw < NM ? (NM - gw + NGW - 1) / NGW : 0; s.fly = -1;
#pragma unroll
    for (int j = 0; j < 8; ++j) s.v[j] = (f32x4){0.f, 0.f, 0.f, 0.f};
}
__device__ __forceinline__ void step_finish(State& s, int l, LAS unsigned char* lds, unsigned char* ws) {
    if (s.fly < 0) return;
    const int tid = hidden_tid(), lane = tid & 63, wave = __builtin_amdgcn_readfirstlane(tid >> 6);
    LAS unsigned* scr = (LAS unsigned*)(lds + SCR_OFF + wave * SCR_BYTES);
    const float* src; unsigned char* dst; int ldw; decode(s.gw + s.fly * s.ngw, l, lds, ws, src, dst, ldw); (void)src; (void)ldw;
    LAS unsigned* wp = scr + (lane >> 3) * 9 + (lane & 7);
#pragma unroll
    for (int j = 0; j < 8; ++j) wp[j * 72] = pk4_fp8(s.v[j].x * W8SCALE, s.v[j].y * W8SCALE, s.v[j].z * W8SCALE, s.v[j].w * W8SCALE);
    asm volatile("" ::: "memory");
    const int ng = lane & 7, kg = lane >> 3; const LAS unsigned* sp = scr + (8 * kg) * 9 + ng;
    const unsigned d0 = sp[0], d1 = sp[9], d2 = sp[18], d3 = sp[27], d4 = sp[36], d5 = sp[45], d6 = sp[54], d7 = sp[63];
    asm volatile("" ::: "memory");
    const unsigned a01l = __builtin_amdgcn_perm(d1, d0, 0x05010400u), a01h = __builtin_amdgcn_perm(d1, d0, 0x07030602u), a23l = __builtin_amdgcn_perm(d3, d2, 0x05010400u), a23h = __builtin_amdgcn_perm(d3, d2, 0x07030602u);
    const unsigned b01l = __builtin_amdgcn_perm(d5, d4, 0x05010400u), b01h = __builtin_amdgcn_perm(d5, d4, 0x07030602u), b23l = __builtin_amdgcn_perm(d7, d6, 0x05010400u), b23h = __builtin_amdgcn_perm(d7, d6, 0x07030602u);
    GAS unsigned char* dp = (GAS unsigned char*)dst + (size_t)(16 * (ng & 1) + 4 * (ng >> 1)) * 1024 + 8 * kg;
    __builtin_nontemporal_store((u32x2){__builtin_amdgcn_perm(a23l, a01l, 0x05040100u), __builtin_amdgcn_perm(b23l, b01l, 0x05040100u)}, (GAS u32x2*)(dp));
    __builtin_nontemporal_store((u32x2){__builtin_amdgcn_perm(a23l, a01l, 0x07060302u), __builtin_amdgcn_perm(b23l, b01l, 0x07060302u)}, (GAS u32x2*)(dp + 1024));
    __builtin_nontemporal_store((u32x2){__builtin_amdgcn_perm(a23h, a01h, 0x05040100u), __builtin_amdgcn_perm(b23h, b01h, 0x05040100u)}, (GAS u32x2*)(dp + 2048));
    __builtin_nontemporal_store((u32x2){__builtin_amdgcn_perm(a23h, a01h, 0x07060302u), __builtin_amdgcn_perm(b23h, b01h, 0x07060302u)}, (GAS u32x2*)(dp + 3072));
    s.fly = -1;
}
__device__ __forceinline__ void step_issue(State& s, int l, LAS unsigned char* lds, unsigned char* ws) {
    if (s.next >= s.end) return;
    const int lane = hidden_tid() & 63;
    const float* src; unsigned char* dst; int ldw; decode(s.gw + s.next * s.ngw, l, lds, ws, src, dst, ldw); (void)dst;
    const GAS float* sp = (const GAS float*)src + (size_t)(lane >> 3) * ldw + 4 * (lane & 7);
#pragma unroll
    for (int j = 0; j < 8; ++j) s.v[j] = __builtin_nontemporal_load((const GAS f32x4*)(sp + (size_t)(8 * j) * ldw));
    s.fly = s.next; s.next += 1;
}
}
constexpr int N_MOE_L = 32 * 16 * 64 + 32 * 16 * 32;
constexpr int N_ITEMS_L = N_MOE_L + 16 * 64 + 16 * 32 + 2 * 4 * 16;
__device__ __forceinline__ void p0_convert(LAS unsigned char* lds, unsigned char* ws, int gw, int NGW, int wave, int lane) {
    cvt_range(0, NLAYER * (N_ITEMS_L - N_MOE_L), 1, lds, ws, gw, NGW, wave, lane);
    for (int i = gw * 64 + lane; i < NLAYER * 32 * 2 * 2 * 64 * 8; i += NGW * 64) {
        const int j = i & 7, ln = (i >> 3) & 63, term = (i >> 9) & 1, eh = (i >> 10) & 1, jj = (i >> 11) & 31, l = i >> 16; const int k = 32 * jj + 8 * (ln >> 4) + j, e = 16 * eh + (ln & 15);
        const float w = ld_in(lds, I_WR)[((size_t)l * D + k) * NEXP + e] * ld_in(lds, I_FFN_NORM)[l * D + k];
        const unsigned hi = f2bf(w); const float rest = w - __builtin_bit_cast(float, hi << 16);
        ((bf16*)(ws + WS_WR2))[i] = (bf16)(term ? f2bf(rest) : hi);
    }
    for (int i = gw * 64 + lane; i < SEQ * 16; i += NGW * 64) { const int pos = i >> 4, fi = i & 15; const float ang = (float)pos * powf(10000.0f, -((float)fi / 16.0f)); float sn, cs; sincosf(ang, &sn, &cs);
        ((float2*)(ws + WS_ROPE))[i] = make_float2(cs, sn); }
}

namespace fg {
constexpr int BK = 64, HALF = 128, HTB = HALF * BK * 2, STAGE_BYTES = 8 * HTB, NXCD = 8, WGM = 8;
constexpr int TAB_OFF = STAGE_BYTES, TAB_BYTES = 4096;
constexpr int EXPTAB_OFF = TAB_OFF + 2 * TAB_BYTES;
constexpr int ULIST_OFF = EXPTAB_OFF + 1024;
constexpr int GAIN_OFF = ULIST_OFF + 1024;
typedef f32x4 Acc[2][2][4][2];
__device__ __forceinline__ int lds_byte(int r, int c) { const int st = (r >> 4) * 2 + (c >> 5), rr = r & 15, cc = c & 31, ob = rr * 64 + cc * 2; return st * 1024 + (ob ^ (((ob >> 9) & 1) << 5)); }
__device__ __forceinline__ void stage_rc(int b, int& R, int& C) { const int st = b / 1024, sb = b % 1024, swz = sb ^ (((sb >> 9) & 1) << 5); R = (st >> 1) * 16 + swz / 64; C = (st & 1) * 32 + (swz % 64) / 2; }
__device__ __forceinline__ unsigned cvt_pk_bf16(float lo, float hi) { unsigned r; asm volatile("v_cvt_pk_bf16_f32 %0, %1, %2" : "=v"(r) : "v"(lo), "v"(hi)); return r; }
struct Unit { int a, b, c, d; };
typedef int v8i32 __attribute__((ext_vector_type(8)));
typedef int v4i32 __attribute__((ext_vector_type(4)));
__device__ __forceinline__ v8i32 cat8(bf16x8 lo, bf16x8 hi) { const v4i32 a = __builtin_bit_cast(v4i32, lo), b = __builtin_bit_cast(v4i32, hi); return (v8i32){a[0], a[1], a[2], a[3], b[0], b[1], b[2], b[3]}; }
typedef f32x4 AccT[2][2][4][2];
__device__ __forceinline__ void acc_zero(AccT& acc) {
#pragma unroll
    for (int a = 0; a < 2; ++a)
#pragma unroll
        for (int b = 0; b < 2; ++b)
#pragma unroll
            for (int m = 0; m < 4; ++m)
#pragma unroll
                for (int n = 0; n < 2; ++n) acc[a][b][m][n] = (f32x4){0.f, 0.f, 0.f, 0.f};
}
struct StaticOrder {
    int nM, nN, nwg, G, c;
    __device__ void init(int M, int N, int G_, int c_) { nM = M / 256; nN = N / 256; nwg = nM * nN; G = G_; c = c_; }
    __device__ bool next(int i, Unit& u) const {
        const long L = (long)i * G + c; if (L >= nwg) return false;
        int wgid = (int)L; { const int q = nwg / NXCD, r = nwg % NXCD, xcd = wgid % NXCD, off = wgid / NXCD; wgid = (xcd < r ? xcd * (q + 1) : r * (q + 1) + (xcd - r) * q) + off; }
        const int nig = WGM * nN, gid = wgid / nig, fm = gid * WGM, gsz = (nM - fm) < WGM ? (nM - fm) : WGM;
        u.a = fm + ((wgid % nig) % gsz); u.b = (wgid % nig) / gsz; u.c = 0; u.d = 0; return true;
    }
};

template <class C>
__device__ __forceinline__ void gemm_phase(LAS unsigned char* lds, const C& cfg) {
    const int tid = hidden_tid(), wid = __builtin_amdgcn_readfirstlane(tid >> 6), lane = tid & 63, wr = wid >> 2, wc = wid & 3, fr = lane & 15, fq = lane >> 4;
    unsigned voffB[1], voffA[C::GATHER ? 4 : 1];
    { int R, Cc; stage_rc(tid * 16, R, Cc); voffB[0] = (unsigned)(R * C::KDB + Cc * 2); if (!C::GATHER) voffA[0] = (unsigned)(R * C::LDAB + Cc * 2); }
#define FG_GATHER_OFFS(par) do { int tz = threadIdx.x; asm volatile("" : "+v"(tz)); _Pragma("unroll") for (int _i = 0; _i < 2; ++_i) { int R, Cc; stage_rc(tz * 16 + _i * 8192, R, Cc); \
        _Pragma("unroll") for (int _h = 0; _h < 2; ++_h) voffA[2 * _h + _i] = (unsigned)Cc * 2u + cfg.a_rowoff(par, _h * 128 + R, lds); } } while (0)
    const size_t kstep = (size_t)(BK * 2), hstep = (size_t)HALF * C::LDAB, hstepB = (size_t)HALF * C::KDB; constexpr int NT = C::KDB / (BK * 2);
    const unsigned ldsw = (unsigned)wid * 1024u;
    const int aoff = lds_byte(wr * 64 + fr, fq * 8), boff = lds_byte(wc * 32 + fr, fq * 8);
#define FG_SA(b, h) (((b) * 2 + (h)) * fg::HTB)
#define FG_SB(b, h) ((4 + (b) * 2 + (h)) * fg::HTB)
#define FG_STAGE(bufoff, gbase, voff, PSTEP) do { _Pragma("unroll") for (int _i = 0; _i < 2; ++_i) { const char* _gb = (const char*)(gbase) + (size_t)_i * (PSTEP); asm volatile("" : "+s"(_gb)); \
        __builtin_amdgcn_global_load_lds((const unsigned*)(_gb + (voff)[(PSTEP) ? 0 : _i]), (LAS unsigned*)(lds + (bufoff) + ldsw + _i * 8192), 16, 0, 0); } } while (0)
#define FG_STAGE_A(bufoff, gbase, h, vo) FG_STAGE(bufoff, (C::GATHER ? (gbase) : (gbase) + (h) * hstep), (C::GATHER ? (vo) + 2 * (h) : (vo)), (C::GATHER ? 0 : 64 * C::LDAB))
#define FG_STAGE_B(bufoff, gbase, h) FG_STAGE(bufoff, (gbase) + (h) * hstepB, voffB, 64 * C::KDB)
#define FG_LDA(dst, b, h) do { _Pragma("unroll") for (int m = 0; m < 4; ++m) _Pragma("unroll") for (int k = 0; k < 2; ++k) dst[m][k] = *(const LAS bf16x8*)(lds + FG_SA(b, h) + aoff + m * 2048 + k * 1024); } while (0)
#define FG_LDB(dst, b, h) do { _Pragma("unroll") for (int n = 0; n < 2; ++n) _Pragma("unroll") for (int k = 0; k < 2; ++k) dst[n][k] = *(const LAS bf16x8*)(lds + FG_SB(b, h) + boff + n * 2048 + k * 1024); } while (0)
#define FG_MMA(ai, bj, At, Bt) do { __builtin_amdgcn_s_setprio(1); _Pragma("unroll") for (int m = 0; m < 4; ++m) _Pragma("unroll") for (int n = 0; n < 2; ++n) { \
        if (C::FP8) { acc[ai][bj][m][n] = __builtin_amdgcn_mfma_scale_f32_16x16x128_f8f6f4(fg::cat8(Bt[n][0], Bt[n][1]), fg::cat8(At[m][0], At[m][1]), acc[ai][bj][m][n], 0, 0, 0, 0, 0, 0); } \
        else { _Pragma("unroll") for (int k = 0; k < 2; ++k) acc[ai][bj][m][n] = __builtin_amdgcn_mfma_f32_16x16x32_bf16(Bt[n][k], At[m][k], acc[ai][bj][m][n], 0, 0, 0); } } \
        __builtin_amdgcn_s_setprio(0); } while (0)
#define FG_WAIT_V(n) asm volatile("s_waitcnt vmcnt(" #n ")" ::: "memory")
#define FG_WAIT_L(n) asm volatile("s_waitcnt lgkmcnt(" #n ")" ::: "memory")
#define FG_BAR __builtin_amdgcn_s_barrier()
#define FG_SCHED __builtin_amdgcn_sched_barrier(0)
    Unit cur, nxt; int ui = 0; int pend = -1;
    if (!cfg.next(0, cur)) return;
    Acc acc;
    bf16x8 At[4][2], B0[2][2], B1[2][2];
    const char* cA = cfg.a_base(cur); const char* cB = cfg.b_base(cur);
    FG_STAGE_B(FG_SB(0, 0), cB, 0); FG_STAGE_B(FG_SB(0, 1), cB, 1);
    cfg.a_ready(cur, 0, lds);
    if (C::GATHER) FG_GATHER_OFFS(0);
    FG_STAGE_A(FG_SA(0, 0), cA, 0, voffA); FG_STAGE_A(FG_SA(0, 1), cA, 1, voffA);
    cfg.acc_init(acc, cur, 0, wr, wc, fr, fq, lds);
    if (wr == 1) FG_BAR;
    FG_WAIT_V(2); FG_BAR;
    FG_STAGE_B(FG_SB(1, 0), cB + kstep, 0); FG_STAGE_A(FG_SA(1, 0), cA + kstep, 0, voffA); FG_STAGE_B(FG_SB(1, 1), cB + kstep, 1);
    FG_WAIT_V(6); FG_BAR;
    for (;;) {
        const bool has_next = cfg.next(ui + 1, nxt);
        const char* nA = has_next ? cfg.a_base(nxt) : cA; const char* nB = has_next ? cfg.b_base(nxt) : cB;
#pragma nounroll
        for (int t = 0; t < NT; t += 2) {
            const bool last = (t == NT - 2);
            const char* a1 = cA + (size_t)(t + 1) * kstep;
            const char* a2 = last ? nA : cA + (size_t)(t + 2) * kstep; const char* b2 = last ? nB : cB + (size_t)(t + 2) * kstep;
            const char* a3 = a2 + kstep; const char* b3 = b2 + kstep;
            if (C::RESCALE) { if (t == 8 || t == 12) cfg.rescale(acc, t, ui & 1, wr, fr, lds); }
            FG_LDB(B0, 0, 0); FG_LDB(B1, 0, 1); FG_SCHED; FG_LDA(At, 0, 0); FG_STAGE_A(FG_SA(1, 1), a1, 1, voffA);
            FG_WAIT_V(8); FG_WAIT_L(0); FG_BAR; FG_MMA(0, 0, At, B0); FG_MMA(0, 1, At, B1); FG_BAR; FG_SCHED;
            if (last && has_next) { cfg.a_ready(nxt, (ui + 1) & 1, lds); if (C::GATHER) FG_GATHER_OFFS((ui + 1) & 1); }
            FG_LDA(At, 0, 1); FG_STAGE_B(FG_SB(0, 0), b2, 0); FG_STAGE_B(FG_SB(0, 1), b2, 1); FG_STAGE_A(FG_SA(0, 0), a2, 0, voffA);
            FG_WAIT_V(8); FG_WAIT_L(0); FG_BAR;
            if (C::PUBLISH) { if (t == 0 && pend >= 0) { cfg.publish(pend); pend = -1; } }
            FG_MMA(1, 0, At, B0); FG_MMA(1, 1, At, B1); FG_BAR; FG_SCHED;
            FG_LDB(B0, 1, 0); FG_LDB(B1, 1, 1); FG_SCHED; FG_LDA(At, 1, 0); FG_STAGE_A(FG_SA(0, 1), a2, 1, voffA);
            FG_WAIT_V(8); FG_WAIT_L(0); FG_BAR; FG_MMA(0, 0, At, B0); FG_MMA(0, 1, At, B1); FG_BAR; FG_SCHED;
            FG_LDA(At, 1, 1); FG_STAGE_B(FG_SB(1, 0), b3, 0); FG_STAGE_B(FG_SB(1, 1), b3, 1); FG_STAGE_A(FG_SA(1, 0), a3, 0, voffA);
            FG_WAIT_V(8); FG_WAIT_L(0); FG_BAR; FG_MMA(1, 0, At, B0); FG_MMA(1, 1, At, B1); FG_BAR; FG_SCHED;
        }
        if (wr == 0) FG_BAR;
        { const int tz = hidden_tid(), wz = __builtin_amdgcn_readfirstlane(tz >> 6), lz = tz & 63;
          cfg.epi(acc, cur, ui & 1, wz >> 2, wz & 3, lz & 15, lz >> 4, lds); }
        if (C::PUBLISH) pend = cfg.pub_id(cur);
        if (!has_next) break;
        cur = nxt; cA = nA; cB = nB; ++ui;
        { const int tz = hidden_tid(), wz = __builtin_amdgcn_readfirstlane(tz >> 6), lz = tz & 63; cfg.acc_init(acc, cur, ui & 1, wz >> 2, wz & 3, lz & 15, lz >> 4, lds); }
        if (wr == 1) FG_BAR;
    }
    FG_WAIT_V(0);
    if (C::PUBLISH) { if (pend >= 0) cfg.publish(pend); }
    FG_BAR;
}

struct HeadParams { bf16* dst; int pitch; const float* gain; float qs; bool norm, pe; float* ssq; };
__device__ __forceinline__ float pair_other(float v, int upper) { const unsigned u = __builtin_bit_cast(unsigned, v); auto rr = __builtin_amdgcn_permlane32_swap(u, u, false, false);
    return __builtin_bit_cast(float, upper ? (unsigned)rr[0] : (unsigned)rr[1]); }
template <class RS>
__device__ __forceinline__ void head_rows(const Acc& acc, const HeadParams& hp, int tile_row0, int wr, int fr, int fq, const RS& rowscale, const unsigned char* ws) {
    f32x4 gv[2][2];
#pragma unroll
    for (int bj = 0; bj < 2; ++bj)
#pragma unroll
        for (int n = 0; n < 2; ++n) gv[bj][n] = (hp.gain && !(hp.pe && bj == 1)) ? *(const f32x4*)(hp.gain + 32 * bj + 8 * fq + 4 * n) * hp.qs : (f32x4){1.f, 1.f, 1.f, 1.f};
#pragma unroll
    for (int ai = 0; ai < 2; ++ai)
#pragma unroll
        for (int m = 0; m < 4; ++m) {
            const int row = tile_row0 + ai * 128 + wr * 64 + m * 16 + fr;
            const float rs = rowscale(row);
            f32x4 v[2][2]; float ss0 = 0.f, ss1 = 0.f;
#pragma unroll
            for (int n = 0; n < 2; ++n) { v[0][n] = acc[ai][0][m][n] * rs; v[1][n] = acc[ai][1][m][n] * rs;
                ss0 += (v[0][n][0] * v[0][n][0] + v[0][n][1] * v[0][n][1]) + (v[0][n][2] * v[0][n][2] + v[0][n][3] * v[0][n][3]);
                ss1 += (v[1][n][0] * v[1][n][0] + v[1][n][1] * v[1][n][1]) + (v[1][n][2] * v[1][n][2] + v[1][n][3] * v[1][n][3]); }
            if (hp.ssq) { float t = ss0 + ss1; t += xor_f<16>(t); t = pair_sum(t); if (fq == 0) hp.ssq[(size_t)row * 8] = t; }
            float sc = 1.f;
            if (hp.norm) { float t = hp.pe ? ss0 : ss0 + ss1; t += xor_f<16>(t); t = pair_sum(t); sc = 1.0f / sqrtf(t * (hp.pe ? (1.f / 32) : (1.f / 64)) + EPS); }
            bf16* rowp = hp.dst + (size_t)row * hp.pitch + 8 * fq;
            if (hp.pe) {
                const f32x4 x0 = v[0][0] * gv[0][0] * sc, x1 = v[0][1] * gv[0][1] * sc;
                f32x4 y0, y1;
#pragma unroll
                for (int q = 0; q < 4; ++q) { y0[q] = pair_other(x0[q], fq >> 1); y1[q] = pair_other(x1[q], fq >> 1); }
                const f32x4* rp = (const f32x4*)((const float*)(ws + WS_ROPE) + ((size_t)(row & (SEQ - 1)) * 16 + 8 * (fq & 1)) * 2);
                const f32x4 t0 = rp[0], t1 = rp[1], t2 = rp[2], t3 = rp[3];
                const float sg = (fq >> 1) ? 1.f : -1.f;
                f32x4 r0, r1;
                r0[0] = x0[0] * t0[0] + sg * y0[0] * t0[1]; r0[1] = x0[1] * t0[2] + sg * y0[1] * t0[3]; r0[2] = x0[2] * t1[0] + sg * y0[2] * t1[1]; r0[3] = x0[3] * t1[2] + sg * y0[3] * t1[3];
                r1[0] = x1[0] * t2[0] + sg * y1[0] * t2[1]; r1[1] = x1[1] * t2[2] + sg * y1[1] * t2[3]; r1[2] = x1[2] * t3[0] + sg * y1[2] * t3[1]; r1[3] = x1[3] * t3[2] + sg * y1[3] * t3[3];
                u32x4 w; w.x = cvt_pk_bf16(r0[0], r0[1]); w.y = cvt_pk_bf16(r0[2], r0[3]); w.z = cvt_pk_bf16(r1[0], r1[1]); w.w = cvt_pk_bf16(r1[2], r1[3]);
                *(u32x4*)rowp = w;
            } else {
#pragma unroll
                for (int bj = 0; bj < 2; ++bj) { const f32x4 v0 = v[bj][0] * gv[bj][0] * sc, v1 = v[bj][1] * gv[bj][1] * sc;
                    u32x4 w; w.x = cvt_pk_bf16(v0[0], v0[1]); w.y = cvt_pk_bf16(v0[2], v0[3]); w.z = cvt_pk_bf16(v1[0], v1[1]); w.w = cvt_pk_bf16(v1[2], v1[3]);
                    *(u32x4*)(rowp + 32 * bj) = w; }
            }
        }
}
template <class RS>
__device__ __forceinline__ void pe_rows(const Acc& acc, bf16* dst, int pitch, const float* gain, float qs, int tile_row0, int wr, int fr, int fq, const RS& rowscale, const unsigned char* ws) {
    const f32x4 g0 = *(const f32x4*)(gain + 8 * fq) * qs, g1 = *(const f32x4*)(gain + 8 * fq + 4) * qs;
    const float sg = (fq >> 1) ? 1.f : -1.f;
#pragma unroll
    for (int am = 0; am < 8; am += 2) {
        f32x4 t[2][4];
#pragma unroll
        for (int mm = 0; mm < 2; ++mm) { const int ai = (am + mm) >> 2, m = (am + mm) & 3; const int row = tile_row0 + ai * 128 + wr * 64 + m * 16 + fr;
            const f32x4* rp = (const f32x4*)((const float*)(ws + WS_ROPE) + ((size_t)(row & (SEQ - 1)) * 16 + 8 * (fq & 1)) * 2);
            t[mm][0] = rp[0]; t[mm][1] = rp[1]; t[mm][2] = rp[2]; t[mm][3] = rp[3]; }
#pragma unroll
        for (int mm = 0; mm < 2; ++mm) {
            const int ai = (am + mm) >> 2, m = (am + mm) & 3;
            const int row = tile_row0 + ai * 128 + wr * 64 + m * 16 + fr;
            const float rs = rowscale(row);
            const f32x4 v0 = acc[ai][0][m][0] * rs, v1 = acc[ai][0][m][1] * rs;
            float ss = (v0[0] * v0[0] + v0[1] * v0[1]) + (v0[2] * v0[2] + v0[3] * v0[3]) + (v1[0] * v1[0] + v1[1] * v1[1]) + (v1[2] * v1[2] + v1[3] * v1[3]);
            ss += xor_f<16>(ss); ss = pair_sum(ss);
            const float sc = 1.0f / sqrtf(ss * (1.f / 32) + EPS);
            const f32x4 x0 = v0 * g0 * sc, x1 = v1 * g1 * sc;
            f32x4 y0, y1;
#pragma unroll
            for (int q = 0; q < 4; ++q) { y0[q] = pair_other(x0[q], fq >> 1); y1[q] = pair_other(x1[q], fq >> 1); }
            f32x4 r0, r1;
            r0[0] = x0[0] * t[mm][0][0] + sg * y0[0] * t[mm][0][1]; r0[1] = x0[1] * t[mm][0][2] + sg * y0[1] * t[mm][0][3]; r0[2] = x0[2] * t[mm][1][0] + sg * y0[2] * t[mm][1][1]; r0[3] = x0[3] * t[mm][1][2] + sg * y0[3] * t[mm][1][3];
            r1[0] = x1[0] * t[mm][2][0] + sg * y1[0] * t[mm][2][1]; r1[1] = x1[1] * t[mm][2][2] + sg * y1[1] * t[mm][2][3]; r1[2] = x1[2] * t[mm][3][0] + sg * y1[2] * t[mm][3][1]; r1[3] = x1[3] * t[mm][3][2] + sg * y1[3] * t[mm][3][3];
            u32x4 w; w.x = cvt_pk_bf16(r0[0], r0[1]); w.y = cvt_pk_bf16(r0[2], r0[3]); w.z = cvt_pk_bf16(r1[0], r1[1]); w.w = cvt_pk_bf16(r1[2], r1[3]);
            *(u32x4*)(dst + (size_t)row * pitch + 8 * fq) = w;
        }
    }
}
struct CfgG1 {
    static constexpr bool GATHER = false, RESCALE = false, FP8 = false; static constexpr int KD = 1024, KDB = 2048, LDAB = 2048;
    StaticOrder S; const bf16* A; const bf16* Bt; unsigned char* ws; const float* rstd;
    const float* aqn; const float* akn; const float* cqn; const float* ckn; const float* bkn;
    __device__ __forceinline__ bool next(int i, Unit& u) const { return S.next(i, u); }
    __device__ __forceinline__ const char* a_base(const Unit& u) const { return (const char*)A + (size_t)u.a * 256 * KD * 2; }
    __device__ __forceinline__ const char* b_base(const Unit& u) const { return (const char*)Bt + (size_t)u.b * 256 * KD * 2; }
    __device__ __forceinline__ void a_ready(const Unit& u, int par, LAS unsigned char* lds) const {
        const int tx = hidden_tid();
        if (tx < 256) *(LAS float*)(lds + TAB_OFF + par * TAB_BYTES + tx * 4) = rstd[u.a * 256 + tx];
    }
    __device__ __forceinline__ unsigned a_rowoff(int, int, LAS unsigned char*) const { return 0u; }
    __device__ __forceinline__ void acc_init(Acc& acc, const Unit&, int, int, int, int, int, LAS unsigned char*) const { acc_zero(acc); }
    static constexpr bool PUBLISH = false; __device__ __forceinline__ void publish(int) const {} __device__ __forceinline__ int pub_id(const Unit&) const { return -1; }
    __device__ __forceinline__ void rescale(Acc&, int, int, int, int, LAS unsigned char*) const {}
    __device__ __forceinline__ void epi(const Acc& acc, const Unit& u, int par, int wr, int wc, int fr, int fq, LAS unsigned char* lds) const {
        const int hh = u.b * 4 + wc;
        const int npass = hh == 30 ? 2 : 1;
        for (int pass = 0; pass < npass; ++pass) {
            HeadParams hp; hp.gain = nullptr; hp.qs = 1.f; hp.norm = false; hp.pe = false; hp.ssq = nullptr;
            if (pass == 1) { hp.dst = (bf16*)(ws + WS_KPE); hp.pitch = 32; hp.gain = bkn + 64; hp.norm = true; hp.pe = true; }
            else if (hh < 8) { hp.dst = (bf16*)(ws + WS_QA) + hh * 64; hp.pitch = 512; hp.gain = aqn; hp.qs = QSCALE_AC; hp.norm = true; }
            else if (hh < 10) { hp.dst = (bf16*)(ws + WS_KA) + (hh - 8) * 64; hp.pitch = 128; hp.gain = akn; hp.norm = true; }
            else if (hh < 12) { hp.dst = (bf16*)(ws + WS_VA) + (hh - 10) * 64; hp.pitch = 128; }
            else if (hh < 16) { hp.dst = (bf16*)(ws + WS_QC) + (hh - 12) * 64; hp.pitch = 256; hp.gain = cqn; hp.qs = QSCALE_AC; hp.norm = true; }
            else if (hh < 20) { hp.dst = (bf16*)(ws + WS_KC) + (hh - 16) * 64; hp.pitch = 256; hp.gain = ckn; hp.norm = true; }
            else if (hh < 24) { hp.dst = (bf16*)(ws + WS_VC) + (hh - 20) * 64; hp.pitch = 256; }
            else { hp.dst = (bf16*)(ws + WS_BRAW) + (hh - 24) * 64; hp.pitch = 512; if (hh < 30) hp.ssq = (float*)(ws + WS_BSS) + (hh - 24); }
            const LAS float* rsp = (const LAS float*)(lds + TAB_OFF + par * TAB_BYTES) - u.a * 256;
            if (pass == 1) pe_rows(acc, hp.dst, hp.pitch, hp.gain, hp.qs, u.a * 256, wr, fr, fq, [rsp](int row) { return rsp[row]; }, ws);
            else head_rows(acc, hp, u.a * 256, wr, fr, fq, [rsp](int row) { return rsp[row]; }, ws);
        }
    }
};
struct CfgGB {
    static constexpr bool GATHER = false, RESCALE = false, FP8 = false; static constexpr int KD = 256, KDB = 512, LDAB = 1024;
    int G, c, layer; unsigned char* ws; const float* bqn; const float* bkn;
    __device__ __forceinline__ bool next(int i, Unit& u) const { const int L = i * G + c; if (L >= 256) return false; u.a = L >> 2; u.b = (L >> 1) & 1; u.c = L & 1; u.d = 0; return true; }
    __device__ __forceinline__ const char* a_base(const Unit& u) const { return (const char*)(ws + WS_BRAW) + ((size_t)u.a * 256 * 512 + u.b * 256) * 2; }
    __device__ __forceinline__ const char* b_base(const Unit& u) const { return (const char*)(ws + WS_WB) + ((((size_t)layer * 2 + u.b) * 512 + u.c * 256) * 256) * 2; }
    __device__ __forceinline__ void a_ready(const Unit& u, int par, LAS unsigned char* lds) const {
        const int tx = hidden_tid();
        if (tx < 256) { const float* bss = (const float*)(ws + WS_BSS) + (size_t)(u.a * 256 + tx) * 8; const f32x4 a = *(const f32x4*)bss, b = *(const f32x4*)(bss + 4);
            *(LAS float*)(lds + TAB_OFF + par * TAB_BYTES + tx * 4) = u.b == 0 ? 1.0f / sqrtf(((a[0] + a[1]) + (a[2] + a[3])) * (1.f / 256) + EPS) : 1.0f / sqrtf((b[0] + b[1]) * (1.f / 128) + EPS); }
    }
    __device__ __forceinline__ unsigned a_rowoff(int, int, LAS unsigned char*) const { return 0u; }
    __device__ __forceinline__ void acc_init(Acc& acc, const Unit&, int, int, int, int, int, LAS unsigned char*) const { acc_zero(acc); }
    static constexpr bool PUBLISH = false; __device__ __forceinline__ void publish(int) const {} __device__ __forceinline__ int pub_id(const Unit&) const { return -1; }
    __device__ __forceinline__ void rescale(Acc&, int, int, int, int, LAS unsigned char*) const {}
    __device__ __forceinline__ void epi(const Acc& acc, const Unit& u, int par, int wr, int wc, int fr, int fq, LAS unsigned char* lds) const {
        HeadParams hp; hp.gain = nullptr; hp.qs = 1.f; hp.norm = false; hp.pe = false; hp.ssq = nullptr;
        if (u.b == 0 && u.c == 0) { hp.dst = (bf16*)(ws + WS_QB) + wc * 96; hp.pitch = 384; hp.gain = bqn; hp.qs = QSCALE_B; hp.norm = true; }
        else if (u.b == 0) { hp.dst = (bf16*)(ws + WS_QB) + wc * 96 + 64; hp.pitch = 384; hp.gain = bqn + 64; hp.qs = QSCALE_B; hp.norm = true; hp.pe = true; }
        else if (u.c == 0) { hp.dst = (bf16*)(ws + WS_KBN) + wc * 64; hp.pitch = 256; hp.gain = bkn; hp.norm = true; }
        else { hp.dst = (bf16*)(ws + WS_VB) + wc * 64; hp.pitch = 256; }
        const LAS float* rsp = (const LAS float*)(lds + TAB_OFF + par * TAB_BYTES) - u.a * 256;
        if (hp.pe) pe_rows(acc, hp.dst, hp.pitch, hp.gain, hp.qs, u.a * 256, wr, fr, fq, [rsp](int row) { return rsp[row]; }, ws);
        else head_rows(acc, hp, u.a * 256, wr, fr, fq, [rsp](int row) { return rsp[row]; }, ws);
    }
};

struct CfgG2 {
    static constexpr bool GATHER = false, RESCALE = true, FP8 = false; static constexpr int KD = 1024, KDB = 2048, LDAB = 2048;
    StaticOrder S; const bf16* A; const bf16* Bt; unsigned char* ws; const bf16* xin; bf16* xout; const float* fgain;
    __device__ __forceinline__ bool next(int i, Unit& u) const { return S.next(i, u); }
    __device__ __forceinline__ const char* a_base(const Unit& u) const { return (const char*)A + (size_t)u.a * 256 * KD * 2; }
    __device__ __forceinline__ const char* b_base(const Unit& u) const { return (const char*)Bt + (size_t)u.b * 256 * KD * 2; }
    __device__ __forceinline__ unsigned a_rowoff(int, int, LAS unsigned char*) const { return 0u; }
    __device__ __forceinline__ void a_ready(const Unit& u, int par, LAS unsigned char* lds) const {
        const int tx = hidden_tid();
        if (tx < 256) {
            const float* o = (const float*)(ws + WS_OSS) + (size_t)(u.a * 256 + tx) * 16;
            const f32x4 s0 = *(const f32x4*)o, s1 = *(const f32x4*)(o + 4), s2 = *(const f32x4*)(o + 8), s3 = *(const f32x4*)(o + 12);
            const float sa = (s0[0] + s0[1] + s0[2] + s0[3]) + (s1[0] + s1[1] + s1[2] + s1[3]), sb = s2[0] + s2[1] + s2[2] + s2[3], sc = s3[0] + s3[1] + s3[2] + s3[3];
            const float ra = 1.0f / sqrtf(sa * (1.f / 512) + EPS), rb = 1.0f / sqrtf(sb * (1.f / 256) + EPS), rc = 1.0f / sqrtf(sc * (1.f / 256) + EPS);
            *(LAS f32x4*)(lds + TAB_OFF + par * TAB_BYTES + tx * 16) = (f32x4){ra / rb, rb / rc, rc, 0.f};
            *(LAS float*)(lds + GAIN_OFF + par * 1024 + tx * 4) = fgain[u.b * 256 + tx];
        }
        asm volatile("s_waitcnt lgkmcnt(0)" ::: "memory"); __builtin_amdgcn_s_barrier(); asm volatile("" ::: "memory");
    }
    __device__ __forceinline__ void acc_init(Acc& acc, const Unit& u, int par, int wr, int wc, int fr, int fq, LAS unsigned char* lds) const {
#pragma unroll
        for (int ai = 0; ai < 2; ++ai)
#pragma unroll
            for (int m = 0; m < 4; ++m) {
                const int rl = ai * 128 + wr * 64 + m * 16 + fr; const int row = u.a * 256 + rl;
                const f32x4 f = *(const LAS f32x4*)(lds + TAB_OFF + par * TAB_BYTES + rl * 16);
                const float inv = 1.0f / (f[0] * f[1] * f[2]);
#pragma unroll
                for (int bj = 0; bj < 2; ++bj) { const size_t off = (size_t)row * D + u.b * 256 + bj * 128 + wc * 32 + 8 * fq;
                    const u32x4 xw = *(const u32x4*)(xin + off);
                    acc[ai][bj][m][0] = (f32x4){bflo(xw.x), bfhi(xw.x), bflo(xw.y), bfhi(xw.y)} * inv; acc[ai][bj][m][1] = (f32x4){bflo(xw.z), bfhi(xw.z), bflo(xw.w), bfhi(xw.w)} * inv; }
            }
    }
    static constexpr bool PUBLISH = false; __device__ __forceinline__ void publish(int) const {} __device__ __forceinline__ int pub_id(const Unit&) const { return -1; }
    __device__ __forceinline__ void rescale(Acc& acc, int t, int par, int wr, int fr, LAS unsigned char* lds) const {
        const int which = (t == 8) ? 0 : 1;
#pragma unroll
        for (int ai = 0; ai < 2; ++ai)
#pragma unroll
            for (int m = 0; m < 4; ++m) { const int row = ai * 128 + wr * 64 + m * 16 + fr;
                const float f = *(const LAS float*)(lds + TAB_OFF + par * TAB_BYTES + row * 16 + which * 4);
#pragma unroll
                for (int bj = 0; bj < 2; ++bj)
#pragma unroll
                    for (int n = 0; n < 2; ++n) acc[ai][bj][m][n] = acc[ai][bj][m][n] * f; }
    }
    __device__ __forceinline__ void epi(const Acc& acc, const Unit& u, int par, int wr, int wc, int fr, int fq, LAS unsigned char* lds) const {
#pragma unroll
        for (int ai = 0; ai < 2; ++ai)
#pragma unroll
            for (int m = 0; m < 4; ++m) {
                const int rl = ai * 128 + wr * 64 + m * 16 + fr; const int row = u.a * 256 + rl;
                const float rc = *(const LAS float*)(lds + TAB_OFF + par * TAB_BYTES + rl * 16 + 8);
                float ss = 0.f;
#pragma unroll
                for (int bj = 0; bj < 2; ++bj) {
                    const size_t off = (size_t)row * D + u.b * 256 + bj * 128 + wc * 32 + 8 * fq;
                    const f32x4 x0 = acc[ai][bj][m][0] * rc, x1 = acc[ai][bj][m][1] * rc;
                    ss += (x0[0] * x0[0] + x0[1] * x0[1]) + (x0[2] * x0[2] + x0[3] * x0[3]) + (x1[0] * x1[0] + x1[1] * x1[1]) + (x1[2] * x1[2] + x1[3] * x1[3]);
                    { u32x4 xw; xw.x = cvt_pk_bf16(x0[0], x0[1]); xw.y = cvt_pk_bf16(x0[2], x0[3]); xw.z = cvt_pk_bf16(x1[0], x1[1]); xw.w = cvt_pk_bf16(x1[2], x1[3]); *(u32x4*)(xout + off) = xw; }
                    const f32x4 g0 = *(const LAS f32x4*)(lds + GAIN_OFF + par * 1024 + (bj * 128 + wc * 32 + 8 * fq) * 4), g1 = *(const LAS f32x4*)(lds + GAIN_OFF + par * 1024 + (bj * 128 + wc * 32 + 8 * fq + 4) * 4);
                    u32x2 w; w.x = pk4_fp8(x0[0] * g0[0], x0[1] * g0[1], x0[2] * g0[2], x0[3] * g0[3]); w.y = pk4_fp8(x1[0] * g1[0], x1[1] * g1[1], x1[2] * g1[2], x1[3] * g1[3]);
                    *(u32x2*)(ws + WS_XB8 + off) = w;
                }
                ss += xor_f<16>(ss); ss = pair_sum(ss);
                if (fq == 0) ((float*)(ws + WS_SS1))[(size_t)row * 16 + u.b * 4 + wc] = ss;
            }
    }
};

__device__ __forceinline__ void build_exptab(LAS unsigned char* lds, const unsigned* ctl, int layer, int ntn, int G, int c) {
    LAS int* tab = (LAS int*)(lds + EXPTAB_OFF); const int tx = hidden_tid();
    if (tx < 32) tab[tx] = (int)ld_agent(ctl + CW_CNT + (layer * 32 + tx) * 64);
    __syncthreads();
    if (tx == 0) { int tb = 0; for (int e = 0; e < 32; ++e) { tab[32 + e] = tb * 256; tab[65 + e] = tb; tb += (tab[e] + 255) / 256; } tab[64] = tb * 256; tab[97] = tb; }
    __syncthreads();
    if (tx < 24) {
        int tg, pn;
        if ((G & 7) == 0 && ((G >> 3) % ntn) == 0) { const int x = c & 7, j = c >> 3, tpr = (G >> 3) / ntn, tpx = (tab[97] + 7) >> 3, lt = tx * tpr + j / ntn;
            tg = lt < tpx ? x * tpx + lt : (1 << 20); pn = j % ntn; }
        else { const int L = tx * G + c; tg = L / ntn; pn = L % ntn; }
        i32x4 ent = (i32x4){-1, 0, 0, 0};
        if (tg < tab[97]) { int e = 0; for (int k = 0; k < 32; ++k) e += (tg >= tab[65 + k + 1]) ? 1 : 0; ent = (i32x4){e, tg - tab[65 + e], pn, tab[32 + e] + (tg - tab[65 + e]) * 256}; }
        *(LAS i32x4*)(lds + ULIST_OFF + tx * 16) = ent;
    }
    __syncthreads();
}
struct CfgMA {
    static constexpr bool GATHER = true, RESCALE = false, FP8 = true, PUBLISH = true; static constexpr int KDB = 1024, LDAB = 1024;
    unsigned char* ws; int layer; const float* bgu; LAS unsigned char* ldsb; unsigned* ctl;
    __device__ __forceinline__ bool next(int i, Unit& u) const { if (i >= 24) return false; const i32x4 e = *(const LAS i32x4*)(ldsb + ULIST_OFF + i * 16);
        u.a = __builtin_amdgcn_readfirstlane(e.x); u.b = __builtin_amdgcn_readfirstlane(e.y); u.c = __builtin_amdgcn_readfirstlane(e.z); u.d = __builtin_amdgcn_readfirstlane(e.w); return u.a >= 0; }
    __device__ __forceinline__ const char* a_base(const Unit&) const { return (const char*)(ws + WS_XB8); }
    __device__ __forceinline__ const char* b_base(const Unit& u) const { return (const char*)(ws + WS_WGU) + (((size_t)layer * NEXP + u.a) * 2048 + (size_t)u.c * 256) * KDB; }
    __device__ __forceinline__ void a_ready(const Unit& u, int par, LAS unsigned char* lds) const {
        const int tx = hidden_tid();
        if (tx < 256) {
            const LAS int* tab = (const LAS int*)(lds + EXPTAB_OFF); const int cnt = tab[u.a]; int i = u.b * 256 + tx; if (i >= cnt) i = 0;
            const int pair = ((const int*)(ws + WS_LIST))[(size_t)u.a * LIST_CAP + i]; const int tok = pair >> 2;
            *(LAS int*)(lds + TAB_OFF + par * TAB_BYTES + tx * 4) = tok;
            *(LAS float*)(lds + TAB_OFF + par * TAB_BYTES + 1024 + tx * 4) = ((const float*)(ws + WS_RSTD))[tok];
        }
        asm volatile("s_waitcnt lgkmcnt(0)" ::: "memory"); __builtin_amdgcn_s_barrier(); asm volatile("" ::: "memory");
    }
    __device__ __forceinline__ unsigned a_rowoff(int par, int row, LAS unsigned char* lds) const { return (unsigned)(*(const LAS int*)(lds + TAB_OFF + par * TAB_BYTES + row * 4)) * (unsigned)LDAB; }
    __device__ __forceinline__ void acc_init(Acc& acc, const Unit&, int, int, int, int, int, LAS unsigned char*) const { acc_zero(acc); }
    __device__ __forceinline__ void rescale(Acc&, int, int, int, int, LAS unsigned char*) const {}
    __device__ __forceinline__ void epi(const Acc& acc, const Unit& u, int par, int wr, int wc, int fr, int fq, LAS unsigned char* lds) const {
        const int j0 = 128 * u.c + 32 * wc + 8 * fq; const float* bg = bgu + (size_t)u.a * 2048;
        const f32x4 bgl0 = *(const f32x4*)(bg + j0), bgl1 = *(const f32x4*)(bg + j0 + 4), bli0 = *(const f32x4*)(bg + 1024 + j0), bli1 = *(const f32x4*)(bg + 1024 + j0 + 4);
        const int rbase = u.d;
        bf16* act = (bf16*)(ws + WS_ACT);
#pragma unroll
        for (int ai = 0; ai < 2; ++ai)
#pragma unroll
            for (int m = 0; m < 4; ++m) {
                const int rl = ai * 128 + wr * 64 + m * 16 + fr;
                const float rs = *(const LAS float*)(lds + TAB_OFF + par * TAB_BYTES + 1024 + rl * 4) * W8INV;
                f32x4 gl0 = acc[ai][0][m][0] * rs + bgl0, gl1 = acc[ai][0][m][1] * rs + bgl1, li0 = acc[ai][1][m][0] * rs + bli0, li1 = acc[ai][1][m][1] * rs + bli1;
                float a[8];
#pragma unroll
                for (int q = 0; q < 4; ++q) {
                    float g = fminf(gl0[q], 7.0f), lv = fminf(fmaxf(li0[q], -7.0f), 7.0f);
                    a[q] = g * __builtin_amdgcn_rcpf(1.0f + __builtin_amdgcn_exp2f(-1.702f * LOG2E * g)) * (lv + 1.0f);
                    g = fminf(gl1[q], 7.0f); lv = fminf(fmaxf(li1[q], -7.0f), 7.0f);
                    a[4 + q] = g * __builtin_amdgcn_rcpf(1.0f + __builtin_amdgcn_exp2f(-1.702f * LOG2E * g)) * (lv + 1.0f);
                }
                const unsigned long long w = (unsigned long long)pk4_fp8(a[0], a[1], a[2], a[3]) | ((unsigned long long)pk4_fp8(a[4], a[5], a[6], a[7]) << 32);
                __hip_atomic_store((unsigned long long*)((unsigned char*)act + (size_t)(rbase + rl) * DEXP + j0), w, __ATOMIC_RELAXED, __HIP_MEMORY_SCOPE_AGENT);
            }
    }
    __device__ __forceinline__ void publish(int tile) const { if ((hidden_tid() & 63) == 0) __hip_atomic_fetch_add(ctl + CW_MOE + (layer * 320 + tile) * 16, 1u, __ATOMIC_RELAXED, __HIP_MEMORY_SCOPE_AGENT); }
    __device__ __forceinline__ int pub_id(const Unit& u) const { return u.d >> 8; }
};
struct CfgMB {
    static constexpr bool GATHER = false, RESCALE = false, FP8 = true; static constexpr int KDB = 1024, LDAB = 1024;
    unsigned char* ws; int layer; const float* bdn; LAS unsigned char* ldsb; unsigned* ctl;
    __device__ __forceinline__ bool next(int i, Unit& u) const { if (i >= 24) return false; const i32x4 e = *(const LAS i32x4*)(ldsb + ULIST_OFF + i * 16);
        u.a = __builtin_amdgcn_readfirstlane(e.x); u.b = __builtin_amdgcn_readfirstlane(e.y); u.c = __builtin_amdgcn_readfirstlane(e.z); u.d = __builtin_amdgcn_readfirstlane(e.w); return u.a >= 0; }
    __device__ __forceinline__ const char* a_base(const Unit& u) const { return (const char*)(ws + WS_ACT) + (size_t)u.d * LDAB; }
    __device__ __forceinline__ const char* b_base(const Unit& u) const { return (const char*)(ws + WS_WDN) + (((size_t)layer * NEXP + u.a) * 1024 + (size_t)u.c * 256) * KDB; }
    __device__ __forceinline__ void a_ready(const Unit& u, int par, LAS unsigned char* lds) const {
        const int tx = hidden_tid();
        if (tx < 64) {
            unsigned* cw = ctl + CW_MOE + (layer * 320 + (u.d >> 8)) * 16; unsigned spins = 0;
            while ((unsigned)__builtin_amdgcn_readfirstlane((int)__hip_atomic_load(cw, __ATOMIC_RELAXED, __HIP_MEMORY_SCOPE_AGENT)) < 64u) {
                __builtin_amdgcn_s_sleep(2);
                if ((++spins & 1023u) == 0u) { if (__hip_atomic_load(ctl + CW_TMO, __ATOMIC_RELAXED, __HIP_MEMORY_SCOPE_AGENT) != 0u) break;
                    if (spins > (1u << 22)) { __hip_atomic_store(ctl + CW_TMO, 1u, __ATOMIC_RELAXED, __HIP_MEMORY_SCOPE_AGENT); break; } }
            }
            __builtin_amdgcn_fence(__ATOMIC_ACQUIRE, "agent");
            asm volatile("s_waitcnt vmcnt(0)" ::: "memory");
        }
        if (tx < 256) {
            const LAS int* tab = (const LAS int*)(lds + EXPTAB_OFF); const int cnt = tab[u.a]; const int i = u.b * 256 + tx;
            int pair = -1; float g = 0.f;
            if (i < cnt) { pair = ((const int*)(ws + WS_LIST))[(size_t)u.a * LIST_CAP + i]; g = ((const float*)(ws + WS_GATE))[pair]; }
            *(LAS int*)(lds + TAB_OFF + par * TAB_BYTES + tx * 4) = pair;
            *(LAS float*)(lds + TAB_OFF + par * TAB_BYTES + 1024 + tx * 4) = g;
        }
        asm volatile("s_waitcnt lgkmcnt(0)" ::: "memory"); __builtin_amdgcn_s_barrier(); asm volatile("" ::: "memory");
    }
    __device__ __forceinline__ unsigned a_rowoff(int, int, LAS unsigned char*) const { return 0u; }
    __device__ __forceinline__ void acc_init(Acc& acc, const Unit&, int, int, int, int, int, LAS unsigned char*) const { acc_zero(acc); }
    static constexpr bool PUBLISH = false; __device__ __forceinline__ void publish(int) const {} __device__ __forceinline__ int pub_id(const Unit&) const { return -1; }
    __device__ __forceinline__ void rescale(Acc&, int, int, int, int, LAS unsigned char*) const {}
    __device__ __forceinline__ void epi(const Acc& acc, const Unit& u, int par, int wr, int wc, int fr, int fq, LAS unsigned char* lds) const {
        const int c0 = 256 * u.c + 32 * wc + 8 * fq; const float* bd = bdn + (size_t)u.a * D;
        f32x4 bv[2][2];
#pragma unroll
        for (int bj = 0; bj < 2; ++bj) { bv[bj][0] = *(const f32x4*)(bd + c0 + 128 * bj); bv[bj][1] = *(const f32x4*)(bd + c0 + 128 * bj + 4); }
        bf16* yb = (bf16*)(ws + WS_Y);
#pragma unroll
        for (int ai = 0; ai < 2; ++ai)
#pragma unroll
            for (int m = 0; m < 4; ++m) {
                const int rl = ai * 128 + wr * 64 + m * 16 + fr;
                int pair = *(const LAS int*)(lds + TAB_OFF + par * TAB_BYTES + rl * 4);
                const float g = *(const LAS float*)(lds + TAB_OFF + par * TAB_BYTES + 1024 + rl * 4);
                pair = pair < 0 ? T * TOPK + rl : pair;
#pragma unroll
                for (int bj = 0; bj < 2; ++bj) { const f32x4 v0 = (acc[ai][bj][m][0] * W8INV + bv[bj][0]) * (g * Y8SCALE), v1 = (acc[ai][bj][m][1] * W8INV + bv[bj][1]) * (g * Y8SCALE);
                    u32x2 w; w.x = pk4_fp8(v0[0], v0[1], v0[2], v0[3]); w.y = pk4_fp8(v1[0], v1[1], v1[2], v1[3]);
                    *(u32x2*)((unsigned char*)yb + (size_t)pair * D + c0 + 128 * bj) = w; }
            }
    }
};
}


namespace att {
typedef float f32x16 __attribute__((ext_vector_type(16)));
typedef short s16x4 __attribute__((ext_vector_type(4)));
typedef float f32x2_t __attribute__((ext_vector_type(2))); typedef __bf16 bf16x2_t __attribute__((ext_vector_type(2)));
__device__ __forceinline__ unsigned cvtpk(float lo, float hi) { f32x2_t v = {lo, hi}; bf16x2_t b = __builtin_convertvector(v, bf16x2_t); return __builtin_bit_cast(unsigned, b); }
__device__ __forceinline__ s16x4 vtr(unsigned addr) { return __builtin_bit_cast(s16x4, __builtin_amdgcn_ds_read_tr16_b64_v4i16((LAS s16x4*)(size_t)addr)); }
constexpr int TAB_LDS = 131072;
constexpr int QW_A = 512 * 4, QW_C = 256 * 4;
constexpr int CW_QUEUE = 24576;
__device__ __forceinline__ int swz8(int key) { const int y = (key >> 1) & 7; return ((y & 1) << 2) | (y >> 1); }

template <int KIND>
__device__ __forceinline__ void unit(LAS unsigned char* lds, unsigned char* ws, int b, int n, int kvh, const float* sinks, bgc::State& bg, int lyr) {
    constexpr int NS = KIND == 1 ? 6 : 4;
    constexpr int BUFB = KIND == 1 ? 69632 : 65536;
    constexpr int NPREV = KIND == 0 ? 2 : (KIND == 1 ? 32 : 8);
    constexpr int TABN = KIND == 0 ? 256 : 640, OFF = KIND == 0 ? 191 : 575;
    const int tid = hidden_tid(), lane = tid & 63, wave = __builtin_amdgcn_readfirstlane(tid >> 6), hw = wave >> 1, qh = wave & 1, r32 = lane & 31, hh = lane >> 5;
    const int kslot = KIND == 0 ? 0 : hw;
    const int tok0 = b * SEQ;
    const int tq = tok0 + n * 64 + qh * 32 + r32;
    bf16x8 qf[NS];
    {
        const bf16* qrow = KIND == 0 ? (const bf16*)(ws + WS_QA) + (size_t)tq * 512 + (kvh * 4 + hw) * 64
                         : (KIND == 1 ? (const bf16*)(ws + WS_QB) + (size_t)tq * 384 + hw * 96 : (const bf16*)(ws + WS_QC) + (size_t)tq * 256 + hw * 64);
#pragma unroll
        for (int s = 0; s < NS; ++s) qf[s] = *(const bf16x8*)(qrow + 16 * s + 8 * hh);
    }
    const int kc0 = n - NPREV < 0 ? 0 : n - NPREV;
    const bf16* kg = KIND == 0 ? (const bf16*)(ws + WS_KA) + kvh * 64 : (KIND == 1 ? (const bf16*)(ws + WS_KBN) : (const bf16*)(ws + WS_KC));
    const bf16* vg = KIND == 0 ? (const bf16*)(ws + WS_VA) + kvh * 64 : (KIND == 1 ? (const bf16*)(ws + WS_VB) : (const bf16*)(ws + WS_VC));
    constexpr int PITCH = KIND == 0 ? 128 : 256;
    constexpr int NPC = KIND == 0 ? 2 : 8;
    const int prow = lane >> 3;
    auto issue = [&](int kc, int buf) {
        LAS unsigned char* bb = lds + buf * BUFB;
        const size_t rowbase = (size_t)(tok0 + kc * 64);
#pragma unroll
        for (int j = 0; j < NPC; ++j) {
            const int pc = wave * NPC + j;
            if (KIND == 0) { const int arr = pc >> 3, g = pc & 7; const int pch = ((lane & 7) ^ swz8(g * 8 + prow)) * 8;
                __builtin_amdgcn_global_load_lds((const unsigned*)((arr ? vg : kg) + (rowbase + g * 8 + prow) * PITCH + pch), (LAS unsigned*)(bb + arr * 32768 + g * 1024), 16, 0, 0); }
            else { const int arr = pc >> 5, hd = (pc >> 3) & 3, g = pc & 7; const int pch = ((lane & 7) ^ swz8(g * 8 + prow)) * 8;
                __builtin_amdgcn_global_load_lds((const unsigned*)((arr ? vg : kg) + (rowbase + g * 8 + prow) * PITCH + hd * 64 + pch), (LAS unsigned*)(bb + arr * 32768 + hd * 8192 + g * 1024), 16, 0, 0); }
        }
        if (KIND == 1) { if (wave < 4) { const int row = wave * 16 + (lane >> 2), c = (lane & 3) ^ ((row >> 2) & 3);
            __builtin_amdgcn_global_load_lds((const unsigned*)((const bf16*)(ws + WS_KPE) + (rowbase + row) * 32 + c * 8), (LAS unsigned*)(bb + 65536 + wave * 1024), 16, 0, 0); } }
    };
    unsigned ka[2][4], kpe[2][2], va[2][4];
    { const int x = swz8(r32);
      const int li = lane & 15, g1 = (lane >> 4) & 1, q = li >> 2, pp = li & 3;
#pragma unroll
      for (int bf = 0; bf < 2; ++bf) { const unsigned bb = (unsigned)(size_t)(lds + bf * BUFB);
#pragma unroll
        for (int s = 0; s < 4; ++s) ka[bf][s] = bb + (unsigned)(kslot * 8192 + r32 * 128 + 16 * ((2 * s + hh) ^ x));
#pragma unroll
        for (int s = 0; s < 2; ++s) kpe[bf][s] = bb + (unsigned)(65536 + r32 * 64 + 16 * ((2 * s + hh) ^ ((r32 >> 2) & 3)));
#pragma unroll
        for (int db = 0; db < 2; ++db)
#pragma unroll
            for (int sec = 0; sec < 2; ++sec) { const int key = 8 * sec + 4 * hh + q; const int chunk = 4 * db + 2 * g1 + (pp >> 1);
                va[bf][db * 2 + sec] = bb + (unsigned)(32768 + kslot * 8192 + key * 128 + 16 * (chunk ^ swz8(key)) + 8 * (pp & 1)); } }
    }
    float m_run = KIND == 0 ? sinks[kvh * 4 + hw] * LOG2E : -1e30f, l_run = 0.f;
    f32x16 o0, o1;
#pragma unroll
    for (int r = 0; r < 16; ++r) { o0[r] = 0.f; o1[r] = 0.f; }
    const int qpos = n * 64 + qh * 32 + r32;
    const unsigned tab0 = (unsigned)(size_t)(lds + TAB_LDS + hw * TABN * 4) + (unsigned)((4 * hh - qpos + OFF) * 4);
    auto tile = [&](const unsigned (&kaB)[4], const unsigned (&kpeB)[2], const unsigned (&vaB)[4], int kc) {
        f32x16 sa, sb;
        if (KIND != 1) {
            const unsigned ta = tab0 + (unsigned)(kc * 64 * 4);
#pragma unroll
            for (int r = 0; r < 16; ++r) { sa[r] = *(const LAS float*)(size_t)(ta + ((r & 3) + 8 * (r >> 2)) * 4); sb[r] = *(const LAS float*)(size_t)(ta + (32 + (r & 3) + 8 * (r >> 2)) * 4); }
        } else {
#pragma unroll
            for (int r = 0; r < 16; ++r) { sa[r] = 0.f; sb[r] = 0.f; }
        }
        if (PROBE == 61) { f32x16 da = sa, db = sb;
#pragma unroll
            for (int s = 0; s < 4; ++s) { const bf16x8 k0 = *(const LAS bf16x8*)(size_t)(kaB[s]), k1 = *(const LAS bf16x8*)(size_t)(kaB[s] + 4096);
                da = __builtin_amdgcn_mfma_f32_32x32x16_bf16(k0, qf[s], da, 0, 0, 0); db = __builtin_amdgcn_mfma_f32_32x32x16_bf16(k1, qf[s], db, 0, 0, 0); }
            asm volatile("" :: "v"(da), "v"(db)); }
#pragma unroll
        for (int s = 0; s < 4; ++s) { const bf16x8 k0 = *(const LAS bf16x8*)(size_t)(kaB[s]), k1 = *(const LAS bf16x8*)(size_t)(kaB[s] + 4096);
            sa = __builtin_amdgcn_mfma_f32_32x32x16_bf16(k0, qf[s], sa, 0, 0, 0); sb = __builtin_amdgcn_mfma_f32_32x32x16_bf16(k1, qf[s], sb, 0, 0, 0); }
        if (KIND == 1) {
#pragma unroll
            for (int s = 0; s < 2; ++s) { const bf16x8 k0 = *(const LAS bf16x8*)(size_t)(kpeB[s]), k1 = *(const LAS bf16x8*)(size_t)(kpeB[s] + 2048);
                sa = __builtin_amdgcn_mfma_f32_32x32x16_bf16(k0, qf[4 + s], sa, 0, 0, 0); sb = __builtin_amdgcn_mfma_f32_32x32x16_bf16(k1, qf[4 + s], sb, 0, 0, 0); }
        }
        float bm = fmaxf(sa[0], sb[0]);
#pragma unroll
        for (int r = 1; r < 16; ++r) bm = fmaxf(bm, fmaxf(sa[r], sb[r]));
        bm = pair_max(bm);
        const float m_new = fmaxf(m_run, bm), alpha = __builtin_amdgcn_exp2f(m_run - m_new);
        const bool grow = __any(m_new > m_run);
        m_run = m_new;
        float psum = 0.f; unsigned pka[8], pkb[8];
#pragma unroll
        for (int r = 0; r < 16; r += 2) {
            const float p0 = __builtin_amdgcn_exp2f(sa[r] - m_new), p1 = __builtin_amdgcn_exp2f(sa[r + 1] - m_new), p2 = __builtin_amdgcn_exp2f(sb[r] - m_new), p3 = __builtin_amdgcn_exp2f(sb[r + 1] - m_new);
            psum += (p0 + p1) + (p2 + p3); pka[r >> 1] = cvtpk(p0, p1); pkb[r >> 1] = cvtpk(p2, p3); }
        l_run = l_run * alpha + psum;
        if (PROBE == 62) { float ps2 = 0.f; float mm = m_new; asm volatile("" : "+v"(mm));
#pragma unroll
            for (int r = 0; r < 16; ++r) { const float p0 = __builtin_amdgcn_exp2f(sa[r] - mm), p2 = __builtin_amdgcn_exp2f(sb[r] - mm); ps2 += p0 + p2; asm volatile("" :: "v"(cvtpk(p0, p2))); }
            asm volatile("" :: "v"(ps2)); }
        if (grow) {
#pragma unroll
            for (int r = 0; r < 16; ++r) { o0[r] *= alpha; o1[r] *= alpha; }
        }
#define ATT_VTR(dst, addr, off) asm volatile("ds_read_b64_tr_b16 %0, %1 offset:%c2" : "=&v"(dst) : "v"(addr), "i"(off) : "memory")
#pragma unroll
        for (int half = 0; half < 2; ++half) {
            s16x4 lo0[2], hi0[2], lo1[2], hi1[2];
#pragma unroll
            for (int k2 = 0; k2 < 2; ++k2) {
                if (half == 0 && k2 == 0) { ATT_VTR(lo0[0], vaB[0], 0); ATT_VTR(hi0[0], vaB[1], 0); ATT_VTR(lo1[0], vaB[2], 0); ATT_VTR(hi1[0], vaB[3], 0); }
                if (half == 0 && k2 == 1) { ATT_VTR(lo0[1], vaB[0], 2048); ATT_VTR(hi0[1], vaB[1], 2048); ATT_VTR(lo1[1], vaB[2], 2048); ATT_VTR(hi1[1], vaB[3], 2048); }
                if (half == 1 && k2 == 0) { ATT_VTR(lo0[0], vaB[0], 4096); ATT_VTR(hi0[0], vaB[1], 4096); ATT_VTR(lo1[0], vaB[2], 4096); ATT_VTR(hi1[0], vaB[3], 4096); }
                if (half == 1 && k2 == 1) { ATT_VTR(lo0[1], vaB[0], 6144); ATT_VTR(hi0[1], vaB[1], 6144); ATT_VTR(lo1[1], vaB[2], 6144); ATT_VTR(hi1[1], vaB[3], 6144); }
            }
            asm volatile("s_waitcnt lgkmcnt(0)" ::: "memory"); __builtin_amdgcn_sched_barrier(0);
            const unsigned* pk = half == 0 ? pka : pkb;
#pragma unroll
            for (int k2 = 0; k2 < 2; ++k2) {
                const bf16x8 pb = __builtin_bit_cast(bf16x8, (u32x4){pk[4 * k2], pk[4 * k2 + 1], pk[4 * k2 + 2], pk[4 * k2 + 3]});
                const bf16x8 v0 = (bf16x8){lo0[k2][0], lo0[k2][1], lo0[k2][2], lo0[k2][3], hi0[k2][0], hi0[k2][1], hi0[k2][2], hi0[k2][3]};
                const bf16x8 v1 = (bf16x8){lo1[k2][0], lo1[k2][1], lo1[k2][2], lo1[k2][3], hi1[k2][0], hi1[k2][1], hi1[k2][2], hi1[k2][3]};
                o0 = __builtin_amdgcn_mfma_f32_32x32x16_bf16(v0, pb, o0, 0, 0, 0);
                o1 = __builtin_amdgcn_mfma_f32_32x32x16_bf16(v1, pb, o1, 0, 0, 0);
                if (PROBE == 63) { f32x16 d0 = o0, d1 = o1; d0 = __builtin_amdgcn_mfma_f32_32x32x16_bf16(v1, pb, d0, 0, 0, 0); d1 = __builtin_amdgcn_mfma_f32_32x32x16_bf16(v0, pb, d1, 0, 0, 0); asm volatile("" :: "v"(d0), "v"(d1)); }
            }
        }
#undef ATT_VTR
    };
    issue(kc0, 0);
    asm volatile("s_waitcnt vmcnt(0) lgkmcnt(0)" ::: "memory"); __builtin_amdgcn_s_barrier(); asm volatile("" ::: "memory");
#define ATT_STEP_WAIT() do { if (bg.fly >= 0) asm volatile("s_waitcnt vmcnt(8) lgkmcnt(0)" ::: "memory"); else asm volatile("s_waitcnt vmcnt(0) lgkmcnt(0)" ::: "memory"); \
        __builtin_amdgcn_s_barrier(); asm volatile("" ::: "memory"); } while (0)
    for (int kc = kc0; kc <= n; kc += 2) {
        bgc::step_finish(bg, lyr, lds, ws);
        if (kc < n) issue(kc + 1, 1);
        if (PROBE == 64 && kc < n) issue(kc + 1, 1);
        asm volatile("" ::: "memory"); bgc::step_issue(bg, lyr, lds, ws); asm volatile("" ::: "memory");
        tile(ka[0], kpe[0], va[0], kc);
        ATT_STEP_WAIT();
        if (kc + 1 > n) break;
        bgc::step_finish(bg, lyr, lds, ws);
        if (kc + 1 < n) issue(kc + 2, 0);
        if (PROBE == 64 && kc + 1 < n) issue(kc + 2, 0);
        asm volatile("" ::: "memory"); bgc::step_issue(bg, lyr, lds, ws); asm volatile("" ::: "memory");
        tile(ka[1], kpe[1], va[1], kc + 1);
        ATT_STEP_WAIT();
    }
#undef ATT_STEP_WAIT
    float l_tot = pair_sum(l_run);
    if (KIND == 0) l_tot += __builtin_amdgcn_exp2f(sinks[kvh * 4 + hw] * LOG2E - m_run);
    const float inv = 1.0f / l_tot;
    const int slot = KIND == 0 ? kvh * 4 + hw : (KIND == 1 ? 8 + hw : 12 + hw);
    bf16* orow = (bf16*)(ws + WS_O) + (size_t)tq * D + slot * 64;
    float ss = 0.f;
#pragma unroll
    for (int g = 0; g < 4; ++g) {
        const float a0 = o0[4 * g] * inv, a1 = o0[4 * g + 1] * inv, a2 = o0[4 * g + 2] * inv, a3 = o0[4 * g + 3] * inv;
        const float c0 = o1[4 * g] * inv, c1 = o1[4 * g + 1] * inv, c2 = o1[4 * g + 2] * inv, c3 = o1[4 * g + 3] * inv;
        ss += (a0 * a0 + a1 * a1) + (a2 * a2 + a3 * a3) + (c0 * c0 + c1 * c1) + (c2 * c2 + c3 * c3);
        u32x2 w0; w0.x = cvtpk(a0, a1); w0.y = cvtpk(a2, a3); *(u32x2*)(orow + 8 * g + 4 * hh) = w0;
        u32x2 w1; w1.x = cvtpk(c0, c1); w1.y = cvtpk(c2, c3); *(u32x2*)(orow + 32 + 8 * g + 4 * hh) = w1;
    }
    ss = pair_sum(ss);
    if (hh == 0) ((float*)(ws + WS_OSS))[(size_t)tq * 16 + slot] = ss;
}

template <int KIND>
__device__ __forceinline__ void build_table(LAS unsigned char* lds, int kvh, const float* t5, const float* crel) {
    constexpr int TABN = KIND == 0 ? 256 : 640, OFF = KIND == 0 ? 191 : 575;
    const int tid = hidden_tid();
    for (int i = tid; i < 4 * TABN; i += NTHREADS) {
        const int h = i / TABN, e = i % TABN, rel = e - OFF; float v;
        if (KIND == 0) v = t5[t5_bucket(rel) * 8 + kvh * 4 + h];
        else { int dist = -rel; dist = dist < -63 ? -63 : (dist > 256 ? 256 : dist); v = crel[(dist + 63) * 4 + h]; }
        *(LAS float*)(lds + TAB_LDS + i * 4) = v * LOG2E;
    }
}

__device__ __forceinline__ void phase(LAS unsigned char* lds, unsigned char* ws, unsigned* ctl, int layer, const float* sinks, const float* t5, const float* crel) {
    volatile LAS int* qslot = (volatile LAS int*)(lds + LDS_BYTES - 64);
    int tabkind = -1;
    const int lyr = layer >> 1, gwv = (int)blockIdx.x * NWAVES + __builtin_amdgcn_readfirstlane(hidden_tid() >> 6);
    bgc::State bg; bgc::init(bg, gwv, (int)gridDim.x * NWAVES);
    for (bool first = true;; first = false) {
        if (hidden_tid() == 0) qslot[0] = first ? (int)blockIdx.x : (int)gridDim.x + (int)__hip_atomic_fetch_add(ctl + CW_QUEUE + 64 * layer, 1u, __ATOMIC_RELAXED, __HIP_MEMORY_SCOPE_AGENT);
        __syncthreads();
        const int u = __builtin_amdgcn_readfirstlane(qslot[0]);
        __syncthreads();
        if (u >= 1024) break;
        if (u < 256) { const int n = 31 - (u >> 3), b = u & 7; tabkind = -1; unit<1>(lds, ws, b, n, 0, sinks, bg, lyr); }
        else if (u < 512) { const int v = u - 256, n = 31 - (v >> 3), b = v & 7;
            if (tabkind != 2) { build_table<2>(lds, 0, t5, crel); tabkind = 2; __syncthreads(); }
            unit<2>(lds, ws, b, n, 0, sinks, bg, lyr); }
        else { const int v = u - 512, kvh = v & 1, b = (v >> 1) & 7, n = 31 - (v >> 4);
            if (tabkind != kvh) { build_table<0>(lds, kvh, t5, crel); tabkind = kvh; __syncthreads(); }
            unit<0>(lds, ws, b, n, kvh, sinks, bg, lyr); }
    }
    bgc::step_finish(bg, lyr, lds, ws);
    if ((hidden_tid() & 63) == 0) ((int*)(ws + WS_TOPI))[gwv] = bg.next;
}
}

#define NREP(slot) (PROBE == (slot) ? 2 : 1)
template <unsigned MASK> __global__ void __launch_bounds__(NTHREADS, 2) fwd(Params p) {
    extern __shared__ __attribute__((aligned(16))) unsigned char lds_raw[];
    LAS unsigned char* lds = (LAS unsigned char*)lds_raw;
    const int G = gridDim.x, bid = blockIdx.x, NGW = G * NWAVES;
#define PHASE_LOCALS const int tid = hidden_tid(); const int lane = tid & 63; const int wave = __builtin_amdgcn_readfirstlane(tid >> 6); const int gw = bid * NWAVES + wave; (void)lane; (void)gw;
    unsigned char* ws = p.ws;
    unsigned* ctl = (unsigned*)(ws + WS_CTL);
    volatile LAS unsigned* MISC = (volatile LAS unsigned*)(lds + LDS_BYTES - 128);
    if (threadIdx.x < 32) MISC[threadIdx.x] = 0u;
    if (threadIdx.x == 0) {
#pragma unroll
        for (int i = 0; i < 27; ++i) { const unsigned long long a = (unsigned long long)p.in[i]; *(LAS u32x2*)(lds + PTAB_OFF + i * 8) = (u32x2){(unsigned)a, (unsigned)(a >> 32)}; }
    }
    __syncthreads();
#define PIN(i) ld_in(lds, (i))
    XcdBarrier bar; bar.bar = ctl + CW_BAR; bar.x = 0; bar.st = nullptr;
    if (MK_ONE_LAUNCH) bar = xcd_barrier_post(ctl + CW_BAR, MISC + 8);
    const int lo = p.ph_lo, hi = p.ph_hi;
#define IN(k) (lo <= (k) && (k) < hi)
#define SEAM(k) do { if (MK_ONE_LAUNCH && (k) + 1 < hi) { xcd_barrier_impl(bar.bar, bar.x, bar.st); if (PROBE == 99) xcd_barrier_impl(bar.bar, bar.x, bar.st); } } while (0)
#define RSTD ((float*)(ws + WS_RSTD))
#define SS1 ((float*)(ws + WS_SS1))
#define GATE ((float*)(ws + WS_GATE))
#define LIST ((int*)(ws + WS_LIST))
#define XB ((bf16*)(ws + WS_XB))
#define OB ((bf16*)(ws + WS_O))
#define YB ((bf16*)(ws + WS_Y))
#define X1 ((bf16*)(ws + WS_X1))
    float* XOUT = p.out;

    if (((MASK >> 15) & 1) && IN(0)) {
        PHASE_LOCALS
        for (int rep = 0; rep < NREP(15); ++rep) p0_convert(lds, ws, gw, NGW, wave, lane);
    }
    for (int l = 0; l < NLAYER + 1; ++l) {
        const int PB = 1 + 16 * l;
        if (((MASK >> 0) & 1) && IN(PB + 0)) {
            PHASE_LOCALS
            const float* xin = PIN(I_X);
            for (int rep = 0; rep < NREP(0); ++rep) {
              if (l == 0) {
                for (int t0 = gw; t0 < T; t0 += 2 * NGW) {
                    const int t1 = t0 + NGW < T ? t0 + NGW : t0;
                    f32x4 v[2][4];
#pragma unroll
                    for (int r = 0; r < 2; ++r)
#pragma unroll
                        for (int j = 0; j < 4; ++j) v[r][j] = __builtin_nontemporal_load((const f32x4*)(xin + (size_t)(r ? t1 : t0) * D + 256 * j + 4 * lane));
#pragma unroll
                    for (int r = 0; r < 2; ++r) { const int t = r ? t1 : t0; float ss = 0.f;
#pragma unroll
                        for (int j = 0; j < 4; ++j) { const int c = 256 * j + 4 * lane;
                            ss += (v[r][j].x * v[r][j].x + v[r][j].y * v[r][j].y) + (v[r][j].z * v[r][j].z + v[r][j].w * v[r][j].w);
                            uint2 o; o.x = pk2(v[r][j].x, v[r][j].y); o.y = pk2(v[r][j].z, v[r][j].w); *(uint2*)(XB + (size_t)t * D + c) = o; }
                        ss = wave_sum(ss);
                        if (lane == 0) RSTD[t] = 1.0f / sqrtf(ss * (1.0f / D) + EPS);
                    }
                }
              } else {
                for (int t0 = gw; t0 < T; t0 += 2 * NGW) {
                    const int t1 = t0 + NGW < T ? t0 + NGW : t0;
                    f32x4 v[2][4]; unsigned y[2][4][4];
#pragma unroll
                    for (int r = 0; r < 2; ++r) { const int t = r ? t1 : t0;
#pragma unroll
                        for (int j = 0; j < 4; ++j) { const int c = 256 * j + 4 * lane;
                            { const u32x2 xw = __builtin_nontemporal_load((const u32x2*)(X1 + (size_t)t * D + c)); v[r][j] = (f32x4){bflo(xw.x), bfhi(xw.x), bflo(xw.y), bfhi(xw.y)}; }
#pragma unroll
                            for (int k = 0; k < 4; ++k) y[r][j][k] = __builtin_nontemporal_load((const unsigned*)((const unsigned char*)YB + ((size_t)t * 4 + k) * D + c)); } }
#pragma unroll
                    for (int r = 0; r < 2; ++r) { const int t = r ? t1 : t0; float ss = 0.f;
#pragma unroll
                        for (int j = 0; j < 4; ++j) { const int c = 256 * j + 4 * lane;
                            f32x4 ys = (f32x4){0.f, 0.f, 0.f, 0.f};
#pragma unroll
                            for (int k = 0; k < 4; ++k) { const auto lo2 = __builtin_amdgcn_cvt_pk_f32_fp8((int)y[r][j][k], false), hi2 = __builtin_amdgcn_cvt_pk_f32_fp8((int)y[r][j][k], true);
                                ys.x += lo2[0]; ys.y += lo2[1]; ys.z += hi2[0]; ys.w += hi2[1]; }
                            v[r][j] = v[r][j] + ys * Y8INV;
                            ss += (v[r][j].x * v[r][j].x + v[r][j].y * v[r][j].y) + (v[r][j].z * v[r][j].z + v[r][j].w * v[r][j].w);
                            if (l == NLAYER) *(f32x4*)(XOUT + (size_t)t * D + c) = v[r][j];
                            if (l < NLAYER) { uint2 o; o.x = pk2(v[r][j].x, v[r][j].y); o.y = pk2(v[r][j].z, v[r][j].w); *(uint2*)(XB + (size_t)t * D + c) = o; }
                        }
                        ss = wave_sum(ss);
                        if (lane == 0 && l < NLAYER) RSTD[t] = 1.0f / sqrtf(ss * (1.0f / D) + EPS);
                    }
                }
              }
            }
            SEAM(PB + 0);
        }
        if (l == NLAYER) break;
        if (((MASK >> 1) & 1) && IN(PB + 1)) {
            PHASE_LOCALS
            fg::CfgG1 cfg; cfg.S.init(T, 2048, G, bid); cfg.A = XB; cfg.Bt = (const bf16*)(ws + WS_WIN) + (size_t)l * 2048 * 1024; cfg.ws = ws; cfg.rstd = RSTD;
            cfg.aqn = PIN(I_AQN) + l * 64; cfg.akn = PIN(I_AKN) + l * 64; cfg.cqn = PIN(I_CQN) + l * 64; cfg.ckn = PIN(I_CKN) + l * 64; cfg.bkn = PIN(I_BKN) + l * 96;
            for (int rep = 0; rep < NREP(1); ++rep) fg::gemm_phase(lds, cfg);
            SEAM(PB + 1);
        }
        if (((MASK >> 4) & 1) && IN(PB + 4)) {
            PHASE_LOCALS
            fg::CfgGB cfg; cfg.G = G; cfg.c = bid; cfg.layer = l; cfg.ws = ws; cfg.bqn = PIN(I_BQN) + l * 96; cfg.bkn = PIN(I_BKN) + l * 96;
            for (int rep = 0; rep < NREP(4); ++rep) fg::gemm_phase(lds, cfg);
            SEAM(PB + 4);
        }
        if (((MASK >> 6) & 1) && IN(PB + 6)) {
            PHASE_LOCALS
            const float* t5 = PIN(I_T5); const float* sinks = PIN(I_ASINK) + l * 8; const float* crel = PIN(I_CREL) + (size_t)l * 320 * 4;
            for (int rep = 0; rep < NREP(6); ++rep) att::phase(lds, ws, ctl, l * 2 + rep, sinks, t5, crel);
            SEAM(PB + 6);
        }
        if (((MASK >> 8) & 1) && IN(PB + 8)) {
            PHASE_LOCALS
            fg::CfgG2 cfg; cfg.S.init(T, 1024, G, bid); cfg.A = OB; cfg.Bt = (const bf16*)(ws + WS_WOUT) + (size_t)l * 1024 * 1024; cfg.ws = ws;
            cfg.xin = XB; cfg.xout = X1; cfg.fgain = PIN(I_FFN_NORM) + l * D;
            for (int rep = 0; rep < NREP(8); ++rep) fg::gemm_phase(lds, cfg);
            SEAM(PB + 8);
        }
        if (((MASK >> 10) & 1) && IN(PB + 10)) {
            PHASE_LOCALS
            const float* br = PIN(I_BR) + l * NEXP;
            LAS float* lg = (LAS float*)(lds);
            LAS int* pe = (LAS int*)(lds + 65536);
            const bf16* wr2 = (const bf16*)(ws + WS_WR2) + (size_t)l * 32 * 2 * 2 * 64 * 8;
            for (int rep = 0; rep < NREP(10); ++rep)
            for (int tb = bid * 64; tb < T; tb += G * 64) {
                {
                    const int tg = wave >> 1, eh = wave & 1, tok = tb + 16 * tg + (lane & 15), kq = lane >> 4;
                    const bf16* xp = X1 + (size_t)tok * D + 8 * kq; const bf16* wp = wr2 + ((size_t)eh * 128 + lane) * 8;
                    f32x4 acc = (f32x4){0.f, 0.f, 0.f, 0.f};
#pragma unroll 1
                    for (int j0 = 0; j0 < 32; j0 += 16) {
                        bf16x8 aw[16], bh[16], bm[16];
#pragma unroll
                        for (int q = 0; q < 16; ++q) { aw[q] = *(const bf16x8*)(xp + 32 * (j0 + q)); bh[q] = *(const bf16x8*)(wp + (size_t)(j0 + q) * 2048); bm[q] = *(const bf16x8*)(wp + (size_t)(j0 + q) * 2048 + 512); }
                        __builtin_amdgcn_sched_barrier(0);
#pragma unroll
                        for (int q = 0; q < 16; ++q) { acc = __builtin_amdgcn_mfma_f32_16x16x32_bf16(aw[q], bh[q], acc, 0, 0, 0); acc = __builtin_amdgcn_mfma_f32_16x16x32_bf16(aw[q], bm[q], acc, 0, 0, 0); }
                    }
#pragma unroll
                    for (int r = 0; r < 4; ++r) lg[(16 * tg + (lane >> 4) * 4 + r) * 32 + 16 * eh + (lane & 15)] = acc[r];
                }
                __syncthreads();
                float svp[4];
#pragma unroll
                for (int it = 0; it < 4; ++it) { const int t = tb + wave * 8 + it * 2 + (lane >> 5), e = lane & 31; svp[it] = e < 16 ? SS1[(size_t)t * 16 + e] : 0.f; }
                const float bre = br[lane & 31];
#pragma unroll
                for (int it = 0; it < 4; ++it) {
                    const int tl = wave * 8 + it * 2 + (lane >> 5), t = tb + tl, e = lane & 31;
                    float sv = svp[it];
                    sv += xor_f<1>(sv); sv += xor_f<2>(sv); sv += xor_f<4>(sv); sv += xor_f<8>(sv); sv += xor_f<16>(sv);
                    const float rs = 1.0f / sqrtf(sv * (1.f / D) + EPS);
                    if (e == 0) RSTD[t] = rs;
                    float lv = lg[tl * 32 + e] * rs + bre; int ti[4]; float tv[4];
#pragma unroll
                    for (int r = 0; r < 4; ++r) {
                        float bv = lv; int bi = e;
#define TOPK_STEP(O) { const float ov = xor_f<O>(bv); const int oi = xor_i<O>(bi); if (ov > bv || (ov == bv && oi < bi)) { bv = ov; bi = oi; } }
                        TOPK_STEP(1) TOPK_STEP(2) TOPK_STEP(4) TOPK_STEP(8) TOPK_STEP(16)
#undef TOPK_STEP
                        ti[r] = bi; tv[r] = bv; if (e == bi) lv = -3.0e38f;
                    }
                    const float e0 = 1.f, e1 = expf(tv[1] - tv[0]), e2 = expf(tv[2] - tv[0]), e3 = expf(tv[3] - tv[0]); const float inv = 1.0f / (e0 + e1 + e2 + e3);
                    if (e == 0) { *(f32x4*)(GATE + (size_t)t * 4) = (f32x4){e0 * inv, e1 * inv, e2 * inv, e3 * inv};
                        const int lp = tl * 4; pe[lp] = ti[0]; pe[lp + 1] = ti[1]; pe[lp + 2] = ti[2]; pe[lp + 3] = ti[3]; }
                }
                __syncthreads();
                LAS int* wcnt = (LAS int*)(lds + 65536 + 1024);
                LAS int* gbase = (LAS int*)(lds + 65536 + 1536);
                int myexp = 0, myrank = 0;
                if (tid < 256) {
                    myexp = pe[tid]; int cntx = 0;
                    for (int x = 0; x < 32; ++x) { const unsigned long long mk = __ballot(myexp == x);
                        if (myexp == x) myrank = (int)__builtin_amdgcn_mbcnt_hi((unsigned)(mk >> 32), __builtin_amdgcn_mbcnt_lo((unsigned)mk, 0u));
                        if (lane == x) cntx = __builtin_popcountll(mk); }
                    if (lane < 32) wcnt[wave * 32 + lane] = cntx;
                }
                __syncthreads();
                if (tid < 32) { const int c = (wcnt[tid] + wcnt[32 + tid]) + (wcnt[64 + tid] + wcnt[96 + tid]);
                    gbase[tid] = (int)__hip_atomic_fetch_add(ctl + CW_CNT + ((l * 2 + rep) * 32 + tid) * 64, (unsigned)c, __ATOMIC_RELAXED, __HIP_MEMORY_SCOPE_AGENT); }
                __syncthreads();
                if (tid < 256) { int pos = gbase[myexp] + myrank; for (int w = 0; w < wave; ++w) pos += wcnt[w * 32 + myexp];
                    (LIST + (size_t)rep * NEXP * LIST_CAP)[(size_t)myexp * LIST_CAP + pos] = (tb + (tid >> 2)) * 4 + (tid & 3); }
                __syncthreads();
            }
        }
        if (((MASK >> 10) & 1) && IN(PB + 10)) {
            PHASE_LOCALS
            { bgc::State bg; bgc::init(bg, gw, NGW); bg.next = __builtin_amdgcn_readfirstlane(((const int*)(ws + WS_TOPI))[gw]);
              for (;;) { bgc::step_finish(bg, l, lds, ws); if (bg.next >= bg.end) break; bgc::step_issue(bg, l, lds, ws); } }
            SEAM(PB + 10);
        }
        if (((MASK >> 11) & 1) && IN(PB + 11)) {
            PHASE_LOCALS
            fg::build_exptab(lds, ctl, l * 2, 8, G, bid);
            fg::CfgMA cfg; cfg.ws = ws; cfg.layer = l; cfg.bgu = PIN(I_BGU) + (size_t)l * NEXP * 2048; cfg.ldsb = lds; cfg.ctl = ctl;
            for (int rep = 0; rep < NREP(11); ++rep) fg::gemm_phase(lds, cfg);
            __syncthreads();
        }
        if (((MASK >> 13) & 1) && IN(PB + 13)) {
            PHASE_LOCALS
            fg::build_exptab(lds, ctl, l * 2, 4, G, (G & 7) == 0 ? (((G >> 3) - 1 - (bid >> 3)) << 3) | (bid & 7) : G - 1 - bid);
            fg::CfgMB cfg; cfg.ws = ws; cfg.layer = l; cfg.bdn = PIN(I_BDN) + (size_t)l * NEXP * D; cfg.ldsb = lds; cfg.ctl = ctl;
            for (int rep = 0; rep < NREP(13); ++rep) fg::gemm_phase(lds, cfg);
            SEAM(PB + 13);
        }
    }
#undef IN
#undef SEAM
}

template <unsigned MASK> static void launch_one(int grid, hipStream_t stream, const Params& p) {
    static bool attr_done = false;
    if (!attr_done) { (void)hipFuncSetAttribute((const void*)fwd<MASK>, hipFuncAttributeMaxDynamicSharedMemorySize, LDS_BYTES); attr_done = true; }
    hipLaunchKernelGGL(fwd<MASK>, dim3(grid), dim3(NTHREADS), LDS_BYTES, stream, p);
}
extern "C" void kernel_launch(void* const* d_in, const int* in_sizes, int n_in, void* d_out, int out_size, void* d_ws, size_t ws_size, hipStream_t stream) {
    static int grid = 0;
    if (grid == 0) {
        if (n_in != 27 || out_size != T * D || ws_size < WS_END) { fprintf(stderr, "kernel_launch: unexpected shapes: n_in %d out %d ws %zu\n", n_in, out_size, ws_size); grid = -1; return; }
        int dev = 0, cus = 0;
        if (hipGetDevice(&dev) != hipSuccess || hipDeviceGetAttribute(&cus, hipDeviceAttributeMultiprocessorCount, dev) != hipSuccess) { grid = -1; return; }
        grid = cus;
    }
    if (grid < 0) return;
    (void)hipMemsetAsync((char*)d_ws + WS_CTL, 0, CTL_ZERO_BYTES, stream);
    Params p{};
    for (int i = 0; i < 27; ++i) p.in[i] = (const float*)d_in[i];
    p.out = (float*)d_out; p.ws = (unsigned char*)d_ws;
    const int NPH = 1 + 16 * NLAYER + 1;
#if MK_ONE_LAUNCH
    p.ph_lo = 0; p.ph_hi = NPH;
    launch_one<0xFFFFu>(grid, stream, p);
#else
    for (int ph = 0; ph < NPH; ++ph) {
        const int s = ph == 0 ? 15 : (ph - 1) % 16;
        if (!(s == 15 ? ph == 0 : (s == 0 || s == 1 || s == 4 || s == 6 || s == 8 || s == 10 || s == 11 || s == 13))) continue;
        p.ph_lo = ph; p.ph_hi = ph + 1;
        switch (s) {
            case 0: launch_one<1u << 0>(grid, stream, p); break;   case 1: launch_one<1u << 1>(grid, stream, p); break;
            case 4: launch_one<1u << 4>(grid, stream, p); break;   case 6: launch_one<1u << 6>(grid, stream, p); break;
            case 8: launch_one<1u << 8>(grid, stream, p); break;   case 10: launch_one<1u << 10>(grid, stream, p); break;
            case 11: launch_one<1u << 11>(grid, stream, p); break; case 13: launch_one<1u << 13>(grid, stream, p); break;
            case 15: launch_one<1u << 15>(grid, stream, p); break;
        }
    }
#endif
}
```
